# Optimizing an MI355X kernel written in HIP

```python
import jax
import jax.numpy as jnp
from jax import lax
import numpy as np

D_MODEL = 1024
BATCH = 4
SEQ = 4096
DEPTH = 1

GRID_W = 64
CTX_LEN = 256
HEAD_DIM = 64
A_HEADS = 8
A_KV_HEADS = 2
A_GROUP = A_HEADS // A_KV_HEADS
WINDOW = 128
BLOCK = 128
A_SCALE = HEAD_DIM ** -0.5
MLA_HEADS = 8
MLA_NOPE = 64
MLA_ROPE = 32
MLA_V = 64
MLA_Q_LORA = 384
MLA_KV_LORA = 256
MLA_SCALE = (MLA_NOPE + MLA_ROPE) ** -0.5
A_Q_W = A_HEADS * HEAD_DIM
A_KV_W = A_KV_HEADS * HEAD_DIM
PROJ_SPLITS = (A_Q_W, A_Q_W + A_KV_W, A_Q_W + 2 * A_KV_W, A_Q_W + 2 * A_KV_W + MLA_Q_LORA,
               A_Q_W + 2 * A_KV_W + MLA_Q_LORA + MLA_KV_LORA)
PROJ_WIDTH = A_Q_W + 2 * A_KV_W + MLA_Q_LORA + MLA_KV_LORA + MLA_ROPE
MIX_WIDTH = A_HEADS * HEAD_DIM + MLA_HEADS * MLA_V
N_EXPERTS = 32
TOP_K = 4
D_FF = 1024
SWIGLU_LIMIT = 7.0
SWIGLU_ALPHA = 1.702
MOE_BLOCK = 256
ROPE_BASE = 10000.0
EPS = 1e-6
NEG_INF = -1e30

kernel_name = 'hybrid_swa_mla_moe_dit_layer'


def rms_norm(x, g):
    xf = x.astype(jnp.float32)
    y = xf * lax.rsqrt(jnp.mean(xf * xf, axis=-1, keepdims=True) + EPS)
    return (y * g.astype(jnp.float32)).astype(x.dtype)


def modulate(h, shift, scale):
    return h * (1 + scale) + shift


def axial_rope_tables(rows, rot_dim):
    row = jnp.broadcast_to(jnp.arange(rows, dtype=jnp.float32)[:, None], (rows, GRID_W)).reshape(-1)
    col = jnp.broadcast_to(jnp.arange(GRID_W, dtype=jnp.float32)[None, :], (rows, GRID_W)).reshape(-1)
    quarter = rot_dim // 4
    inv_freq = ROPE_BASE ** (-jnp.arange(quarter, dtype=jnp.float32) / quarter)
    ang = jnp.concatenate([row[:, None] * inv_freq, col[:, None] * inv_freq], axis=-1)
    return jnp.cos(ang), jnp.sin(ang)


def apply_rope(x, cos, sin):
    xf = x.astype(jnp.float32)
    half = xf.shape[-1] // 2
    x1, x2 = xf[..., :half], xf[..., half:]
    c, s = cos[:, None, :], sin[:, None, :]
    return jnp.concatenate([x1 * c - x2 * s, x1 * s + x2 * c], axis=-1).astype(x.dtype)


def windowed_gqa(q, k, v, kc, vc, sink):
    B, S = q.shape[:2]
    C = kc.shape[1]
    nb = S // BLOCK
    qb = q.reshape(B, nb, BLOCK, A_KV_HEADS, A_GROUP, HEAD_DIM)
    pad = ((0, 0), (BLOCK, BLOCK), (0, 0), (0, 0))
    kp = jnp.pad(k, pad).reshape(B, nb + 2, BLOCK, A_KV_HEADS, HEAD_DIM)
    vp = jnp.pad(v, pad).reshape(B, nb + 2, BLOCK, A_KV_HEADS, HEAD_DIM)
    kb = jnp.concatenate([kp[:, :-2], kp[:, 1:-1], kp[:, 2:]], axis=2)
    vb = jnp.concatenate([vp[:, :-2], vp[:, 1:-1], vp[:, 2:]], axis=2)
    n_loc = 3 * BLOCK
    s_loc = jnp.einsum('bnqhgd,bnkhd->bnhgqk', qb, kb, preferred_element_type=jnp.float32) * A_SCALE
    qpos = jnp.arange(nb)[:, None, None] * BLOCK + jnp.arange(BLOCK)[None, :, None]
    kpos = jnp.arange(nb)[:, None, None] * BLOCK - BLOCK + jnp.arange(n_loc)[None, None, :]
    valid = (jnp.abs(qpos - kpos) <= WINDOW) & (kpos >= 0) & (kpos < S)
    s_loc = jnp.where(valid[None, :, None, None], s_loc, NEG_INF)
    s_ctx = jnp.einsum('bnqhgd,bchd->bnhgqc', qb, kc, preferred_element_type=jnp.float32) * A_SCALE
    s_sink = jnp.broadcast_to(sink.astype(jnp.float32).reshape(1, 1, A_KV_HEADS, A_GROUP, 1, 1),
                              s_loc.shape[:-1] + (1,))
    p = jax.nn.softmax(jnp.concatenate([s_loc, s_ctx, s_sink], axis=-1), axis=-1).astype(v.dtype)
    o = (jnp.einsum('bnhgqk,bnkhd->bnqhgd', p[..., :n_loc], vb)
         + jnp.einsum('bnhgqc,bchd->bnqhgd', p[..., n_loc:n_loc + C], vc))
    return o.reshape(B, S, A_HEADS * HEAD_DIM)


def context_gqa(q, k, v, sink):
    B, C = q.shape[:2]
    qg = q.reshape(B, C, A_KV_HEADS, A_GROUP, HEAD_DIM)
    s = jnp.einsum('bqhgd,bkhd->bhgqk', qg, k, preferred_element_type=jnp.float32) * A_SCALE
    s_sink = jnp.broadcast_to(sink.astype(jnp.float32).reshape(1, A_KV_HEADS, A_GROUP, 1, 1), s.shape[:-1] + (1,))
    p = jax.nn.softmax(jnp.concatenate([s, s_sink], axis=-1), axis=-1)[..., :-1].astype(v.dtype)
    return jnp.einsum('bhgqk,bkhd->bqhgd', p, v).reshape(B, C, A_HEADS * HEAD_DIM)


def mla_project(cq, ckv, g_q_a, w_uq, g_kv_a, w_ukv):
    B, N = cq.shape[:2]
    q = (rms_norm(cq, g_q_a) @ w_uq).reshape(B, N, MLA_HEADS, MLA_NOPE + MLA_ROPE)
    kv = (rms_norm(ckv, g_kv_a) @ w_ukv).reshape(B, N, MLA_HEADS, MLA_NOPE + MLA_V)
    return q[..., :MLA_NOPE], q[..., MLA_NOPE:], kv[..., :MLA_NOPE], kv[..., MLA_NOPE:]


def mla_attend(qn, qr, kn, kr, v):
    s = (jnp.einsum('bqhd,bkhd->bhqk', qn, kn, preferred_element_type=jnp.float32)
         + jnp.einsum('bqhd,bkd->bhqk', qr, kr, preferred_element_type=jnp.float32)) * MLA_SCALE
    p = jax.nn.softmax(s, axis=-1).astype(v.dtype)
    return jnp.einsum('bhqk,bkhd->bqhd', p, v)


def mla_latent(qn, qr, kn, kr, v, kn_c, kr_c, v_c):
    B, S = qn.shape[:2]
    nb = S // BLOCK
    kn_all = jnp.concatenate([kn_c, kn], axis=1)
    kr_all = jnp.concatenate([kr_c, kr], axis=1)
    v_all = jnp.concatenate([v_c, v], axis=1)
    qn_b = qn.reshape(B, nb, BLOCK, MLA_HEADS, MLA_NOPE).transpose(1, 0, 2, 3, 4)
    qr_b = qr.reshape(B, nb, BLOCK, MLA_HEADS, MLA_ROPE).transpose(1, 0, 2, 3, 4)
    o = lax.map(lambda qs: mla_attend(qs[0], qs[1], kn_all, kr_all, v_all), (qn_b, qr_b))
    return o.transpose(1, 0, 2, 3, 4).reshape(B, S, MLA_HEADS * MLA_V)


def token_mixing(h, hc, w_in, sink, g_q_a, w_uq, g_kv_a, w_ukv, w_o, rope_a, rope_b, ctx_out):
    B, S, _ = h.shape
    C = hc.shape[1]
    qa, ka, va, cq, ckv, kr = jnp.split(h @ w_in, PROJ_SPLITS, axis=-1)
    qa_c, ka_c, va_c, cq_c, ckv_c, kr_c = jnp.split(hc @ w_in, PROJ_SPLITS, axis=-1)
    qa = apply_rope(qa.reshape(B, S, A_HEADS, HEAD_DIM), *rope_a)
    ka = apply_rope(ka.reshape(B, S, A_KV_HEADS, HEAD_DIM), *rope_a)
    va = va.reshape(B, S, A_KV_HEADS, HEAD_DIM)
    ka_c = ka_c.reshape(B, C, A_KV_HEADS, HEAD_DIM)
    va_c = va_c.reshape(B, C, A_KV_HEADS, HEAD_DIM)
    out_a = windowed_gqa(qa, ka, va, ka_c, va_c, sink)
    qn, qr, kn, vb = mla_project(cq, ckv, g_q_a, w_uq, g_kv_a, w_ukv)
    qr = apply_rope(qr, *rope_b)
    kr = apply_rope(kr[:, :, None, :], *rope_b)[:, :, 0, :]
    qn_c, qr_c, kn_c, vb_c = mla_project(cq_c, ckv_c, g_q_a, w_uq, g_kv_a, w_ukv)
    out_b = mla_latent(qn, qr, kn, kr, vb, kn_c, kr_c, vb_c)
    y = jnp.concatenate([out_a, out_b], axis=-1) @ w_o
    if not ctx_out:
        return y, None
    out_a_c = context_gqa(qa_c.reshape(B, C, A_HEADS, HEAD_DIM), ka_c, va_c, sink)
    out_b_c = mla_attend(qn_c, qr_c, kn_c, kr_c, vb_c).reshape(B, C, MLA_HEADS * MLA_V)
    yc = jnp.concatenate([out_a_c, out_b_c], axis=-1) @ w_o
    return y, yc


def moe_ffn(h, w_router, b_router, w_gate_up, b_gate_up, w_down, b_down):
    shape = h.shape
    d = shape[-1]
    xt = h.reshape(-1, d)
    T = xt.shape[0]
    logits = jnp.einsum('td,de->te', xt, w_router, preferred_element_type=jnp.float32) + b_router.astype(jnp.float32)
    top_logit, top_idx = lax.top_k(logits, TOP_K)
    top_w = jax.nn.softmax(top_logit, axis=-1)
    n_assign = T * TOP_K
    flat_e = top_idx.reshape(-1)
    order = jnp.argsort(flat_e)
    sorted_e = flat_e[order]
    counts = jnp.bincount(flat_e, length=N_EXPERTS)
    padded = (counts + MOE_BLOCK - 1) // MOE_BLOCK * MOE_BLOCK
    pad_end = jnp.cumsum(padded)
    pad_start = pad_end - padded
    start = jnp.cumsum(counts) - counts
    dest = pad_start[sorted_e] + jnp.arange(n_assign) - start[sorted_e]
    n_blocks = -(-n_assign // MOE_BLOCK) + N_EXPERTS
    cap = n_blocks * MOE_BLOCK
    slot_tok = jnp.full((cap,), T, jnp.int32).at[dest].set((order // TOP_K).astype(jnp.int32))
    slot_w = jnp.zeros((cap,), jnp.float32).at[dest].set(top_w.reshape(-1)[order])
    block_e = jnp.minimum(jnp.searchsorted(pad_end, jnp.arange(n_blocks) * MOE_BLOCK, side='right'), N_EXPERTS - 1)
    x_pad = jnp.concatenate([xt, jnp.zeros((1, d), xt.dtype)], axis=0)
    xs = x_pad[slot_tok].reshape(n_blocks, MOE_BLOCK, d)

    def expert_block(args):
        xb, e = args
        gate, lin = jnp.split(xb @ w_gate_up[e] + b_gate_up[e], 2, axis=-1)
        gate = jnp.minimum(gate, SWIGLU_LIMIT)
        lin = jnp.clip(lin, -SWIGLU_LIMIT, SWIGLU_LIMIT)
        act = (lin + 1) * (gate * jax.nn.sigmoid(SWIGLU_ALPHA * gate))
        return act @ w_down[e] + b_down[e]

    ys = lax.map(expert_block, (xs, block_e)).reshape(cap, d)
    ys = ys * slot_w[:, None].astype(ys.dtype)
    out = jnp.zeros((T + 1, d), ys.dtype).at[slot_tok].add(ys)[:T]
    return out.reshape(shape)


def setup_inputs(seed: int = 0) -> dict:
    key = jax.random.key(seed)
    ks = jax.random.split(key, 24)
    f32 = jnp.float32
    L, D = DEPTH, D_MODEL

    def nrm(k, shape, scale):
        return jax.random.normal(k, shape, f32) * scale

    return {
        'x': nrm(ks[0], (BATCH, SEQ, D), 1.0),
        'c': nrm(ks[1], (BATCH, D), 1.0),
        'ctx': nrm(ks[2], (BATCH, CTX_LEN, D), 1.0),
        'c_ctx': nrm(ks[3], (D,), 1.0),
        'w_ada': nrm(ks[4], (L, D, 6 * D), 0.5 * D ** -0.5),
        'b_ada': nrm(ks[5], (L, 6 * D), 0.02),
        'g_mix_pre': 1.0 + nrm(ks[6], (L, D), 0.1),
        'g_mix_post': 1.0 + nrm(ks[7], (L, D), 0.1),
        'w_in': nrm(ks[8], (L, D, PROJ_WIDTH), D ** -0.5),
        'sink': nrm(ks[9], (L, A_HEADS), 1.0),
        'g_q_a': 1.0 + nrm(ks[10], (L, MLA_Q_LORA), 0.1),
        'w_uq': nrm(ks[11], (L, MLA_Q_LORA, MLA_HEADS * (MLA_NOPE + MLA_ROPE)), MLA_Q_LORA ** -0.5),
        'g_kv_a': 1.0 + nrm(ks[12], (L, MLA_KV_LORA), 0.1),
        'w_ukv': nrm(ks[13], (L, MLA_KV_LORA, MLA_HEADS * (MLA_NOPE + MLA_V)), MLA_KV_LORA ** -0.5),
        'w_o': nrm(ks[14], (L, MIX_WIDTH, D), MIX_WIDTH ** -0.5),
        'g_ffn_pre': 1.0 + nrm(ks[15], (L, D), 0.1),
        'g_ffn_post': 1.0 + nrm(ks[16], (L, D), 0.1),
        'w_router': nrm(ks[17], (L, D, N_EXPERTS), D ** -0.5),
        'b_router': nrm(ks[18], (L, N_EXPERTS), 0.01),
        'w_gate_up': nrm(ks[19], (L, N_EXPERTS, D, 2 * D_FF), D ** -0.5),
        'b_gate_up': nrm(ks[20], (L, N_EXPERTS, 2 * D_FF), 0.02),
        'w_down': nrm(ks[21], (L, N_EXPERTS, D_FF, D), D_FF ** -0.5),
        'b_down': nrm(ks[22], (L, N_EXPERTS, D), 0.02),
    }


def reference(x, c, ctx, c_ctx, w_ada, b_ada, g_mix_pre, g_mix_post, w_in, sink, g_q_a, w_uq, g_kv_a, w_ukv,
              w_o, g_ffn_pre, g_ffn_post, w_router, b_router, w_gate_up, b_gate_up, w_down, b_down):
    S = x.shape[1]
    ROWS = S // GRID_W
    rope_a = axial_rope_tables(ROWS, HEAD_DIM)
    rope_b = axial_rope_tables(ROWS, MLA_ROPE)
    silu_c = jax.nn.silu(c)
    silu_cc = jax.nn.silu(c_ctx)
    for l in range(DEPTH):
        ctx_out = l < DEPTH - 1
        mod = jnp.split((silu_c @ w_ada[l] + b_ada[l])[:, None, :], 6, axis=-1)
        mod_c = jnp.split(silu_cc @ w_ada[l] + b_ada[l], 6, axis=-1)
        h = modulate(rms_norm(x, g_mix_pre[l]), mod[0], mod[1])
        hc = modulate(rms_norm(ctx, g_mix_pre[l]), mod_c[0], mod_c[1])
        y, yc = token_mixing(h, hc, w_in[l], sink[l], g_q_a[l], w_uq[l], g_kv_a[l], w_ukv[l], w_o[l],
                             rope_a, rope_b, ctx_out)
        x = x + mod[2] * rms_norm(y, g_mix_post[l])
        h2 = modulate(rms_norm(x, g_ffn_pre[l]), mod[3], mod[4])
        f = moe_ffn(h2, w_router[l], b_router[l], w_gate_up[l], b_gate_up[l], w_down[l], b_down[l])
        x = x + mod[5] * rms_norm(f, g_ffn_post[l])
        if ctx_out:
            ctx = ctx + mod_c[2] * rms_norm(yc, g_mix_post[l])
            hc2 = modulate(rms_norm(ctx, g_ffn_pre[l]), mod_c[3], mod_c[4])
            fc = moe_ffn(hc2, w_router[l], b_router[l], w_gate_up[l], b_gate_up[l], w_down[l], b_down[l])
            ctx = ctx + mod_c[5] * rms_norm(fc, g_ffn_post[l])
    return x
```

```cpp
#include <hip/hip_runtime.h>
#include <stdint.h>
#include <stdio.h>

constexpr int D = 1024, NB = 4, SEQ = 4096, CTX = 256;
constexpr int T = NB * SEQ;
constexpr int TC = NB * CTX;
constexpr int TT = T + TC;
constexpr int NKEY = CTX + SEQ;
constexpr int PROJ_W = 1440, PROJ_WP = 1536;
constexpr int NE = 32, DFF = 1024, CAP_E = 16384;
constexpr int CAPS = (256 + 32) * 256;
constexpr float EPS = 1e-6f;
constexpr float LOG2E = 1.4426950408889634f;
constexpr float A_SCALE_L2 = 0.125f * LOG2E;
constexpr float MLA_SCALE_L2 = 0.10206207261596575f * LOG2E;

typedef unsigned short bf16_t;
typedef float f32x4 __attribute__((ext_vector_type(4)));
typedef unsigned u32x4 __attribute__((ext_vector_type(4)));
typedef unsigned u32x2 __attribute__((ext_vector_type(2)));
#define LAS __attribute__((address_space(3)))
#define GAS __attribute__((address_space(1)))

constexpr size_t MiB = 1u << 20;
constexpr size_t WS_CTL = 0, CTL_BYTES = 1 * MiB;
constexpr size_t WS_MODP = 1 * MiB;
constexpr size_t WS_MODF = 2 * MiB;
constexpr size_t WS_ROPE = 2 * MiB + 512 * 1024;
constexpr size_t WS_TOPE = 3 * MiB, WS_TOPW = 3 * MiB + 256 * 1024, WS_TOPR = 3 * MiB + 512 * 1024;
constexpr size_t WS_TOKL = 4 * MiB;
constexpr size_t WS_WIN = 6 * MiB, WS_WUQ = 9 * MiB, WS_WUKV = 10 * MiB, WS_WO = 11 * MiB;
constexpr size_t WS_RSTD = 13 * MiB;
constexpr size_t WS_WGU = 16 * MiB, WS_WD = 144 * MiB;
constexpr size_t WS_H = 208 * MiB, WS_QA = 242 * MiB, WS_KA = 258 * MiB, WS_VAT = 263 * MiB, WS_CQ = 268 * MiB, WS_CKV = 280 * MiB;
constexpr size_t WS_QB = 289 * MiB, WS_KB = 313 * MiB, WS_VBT = 339 * MiB, WS_ATT = 356 * MiB, WS_Y = 388 * MiB, WS_X1 = 420 * MiB, WS_H2 = 484 * MiB;
constexpr size_t WS_ACT = 516 * MiB, WS_YS = 660 * MiB, WS_END = 804 * MiB;
constexpr size_t WS_PROJ32 = 516 * MiB, WS_Q32 = 612 * MiB, WS_KV32 = 660 * MiB;
constexpr int CW_COUNT = 0;
constexpr int CW_BAR = 4096;

__device__ __forceinline__ float bf2f(bf16_t v) { return __uint_as_float(((unsigned)v) << 16); }
__device__ __forceinline__ unsigned f2bf(float f) { unsigned u = __float_as_uint(f); return (u + 0x7fffu + ((u >> 16) & 1u)) >> 16; }
__device__ __forceinline__ unsigned pk2(float lo, float hi) { return f2bf(lo) | (f2bf(hi) << 16); }
__device__ __forceinline__ float wave_sum(float v) {
#pragma unroll
    for (int o = 1; o < 64; o <<= 1) v += __shfl_xor(v, o);
    return v;
}
__device__ __forceinline__ float wave_max(float v) {
#pragma unroll
    for (int o = 1; o < 64; o <<= 1) v = fmaxf(v, __shfl_xor(v, o));
    return v;
}
__host__ __device__ __forceinline__ int kpos_of(int key) { const int x = key & 15; return (key & ~15) | (8 * ((x >> 2) & 1) + (x & 3) + 4 * (x >> 3)); }
__device__ __forceinline__ void row_bk(int row, int& b, int& key) { if (row < T) { b = row >> 12; key = CTX + (row & 4095); } else { const int r = row - T; b = r >> 8; key = r & 255; } }

struct Args {
    const float* in[23]; float* out; unsigned char* ws; int ph_lo, ph_hi;
};
enum { I_X = 0, I_C, I_CTX, I_CCTX, I_WADA, I_BADA, I_GMIXPRE, I_GMIXPOST, I_WIN, I_SINK, I_GQA, I_WUQ, I_GKVA, I_WUKV, I_WO, I_GFFNPRE, I_GFFNPOST, I_WROUTER, I_BROUTER, I_WGU, I_BGU, I_WD, I_BD };

#define ONE_LAUNCH 1
#define FAST_S2 1
#define FAST_S3 1
#define FAST_S4 1
#define FAST_S5 1
#define FAST_S7 1
#define FAST_S8 1
constexpr int NWAVES = 8, NTHR = 512;
constexpr int LDS_BYTES = 160 * 1024;

struct Frame {
    LAS unsigned char* lds; int tid, lane, wave, vcu, G; unsigned char* ws; float* out;
};

template <class MAP>
__device__ __forceinline__ void transpose_item(const float* W, int K, int N, bf16_t* WT, const float* gk, LAS float* scr, int item, int lane, MAP map) {
    const int nblk = N / 32, kb = item / nblk, nb = item % nblk, k0 = 64 * kb, n0 = 32 * nb;
#pragma unroll 8
    for (int i = 0; i < 32; ++i) { const int kk = 2 * i + (lane >> 5); float v = W[(size_t)(k0 + kk) * N + n0 + (lane & 31)]; if (gk) v *= gk[k0 + kk]; scr[kk * 33 + (lane & 31)] = v; }
    asm volatile("s_waitcnt lgkmcnt(0)" ::: "memory");
    const int c = lane & 7;
#pragma unroll
    for (int j = 0; j < 4; ++j) { const int n = (lane >> 3) + 8 * j; const LAS float* s = scr + (8 * c) * 33 + n;
        u32x4 o; o.x = pk2(s[0 * 33], s[1 * 33]); o.y = pk2(s[2 * 33], s[3 * 33]); o.z = pk2(s[4 * 33], s[5 * 33]); o.w = pk2(s[6 * 33], s[7 * 33]);
        *(u32x4*)(WT + (size_t)map(n0 + n) * K + k0 + 8 * c) = o; }
    asm volatile("s_waitcnt lgkmcnt(0)" ::: "memory");
}
struct MapId { __device__ __forceinline__ int operator()(int n) const { return n; } };
struct MapWin { __device__ __forceinline__ int operator()(int n) const {
    if (n < 640) { const int h = n >> 6, i = n & 63; return (h << 6) + (i < 32 ? 2 * i : 2 * (i - 32) + 1); }
    if (n < 1408) return n;
    const int i = n - 1408; return 1408 + (i < 16 ? 2 * i : 2 * (i - 16) + 1); } };
struct MapWuq { __device__ __forceinline__ int operator()(int n) const {
    const int h = n / 96, i = n % 96; if (i < 64) return n; const int r = i - 64; return h * 96 + 64 + (r < 16 ? 2 * r : 2 * (r - 16) + 1); } };
struct MapWgu { __device__ __forceinline__ int operator()(int n) const {
    if (n < 1024) return 256 * (n >> 7) + (n & 127); const int m = n - 1024; return 256 * (m >> 7) + 128 + (m & 127); } };

__device__ __forceinline__ void ph0_prologue(Frame& F, const Args& A) {
    LAS float* sil = (LAS float*)F.lds;
    const float* c = A.in[I_C]; const float* cc = A.in[I_CCTX];
    for (int i = F.tid; i < 5 * 1024; i += NTHR) { const int v = i >> 10, k = i & 1023; const float x = v < 4 ? c[v * 1024 + k] : cc[k]; sil[i] = x / (1.f + expf(-x)); }
    __syncthreads();
    const int gw = F.vcu * NWAVES + F.wave, NGW = F.G * NWAVES, lane = F.lane;
    { const float* W = A.in[I_WADA]; float* MODP = (float*)(F.ws + WS_MODP);
      for (int it = gw; it < 96 * 8; it += NGW) { const int nc = it % 96, ks = it / 96, n = nc * 64 + lane;
          float a0 = 0.f, a1 = 0.f, a2 = 0.f, a3 = 0.f, a4 = 0.f;
#pragma unroll 8
          for (int k = ks * 128; k < ks * 128 + 128; ++k) { const float w = W[(size_t)k * 6144 + n];
              a0 += sil[k] * w; a1 += sil[1024 + k] * w; a2 += sil[2048 + k] * w; a3 += sil[3072 + k] * w; a4 += sil[4096 + k] * w; }
          float* o = MODP + (size_t)(ks * 5) * 6144 + n; o[0] = a0; o[6144] = a1; o[2 * 6144] = a2; o[3 * 6144] = a3; o[4 * 6144] = a4; } }
    if (blockIdx.x == 0) { float* R = (float*)(F.ws + WS_ROPE);
        for (int i = F.tid; i < 64 * 16; i += NTHR) { const int p = i >> 4, j = i & 15; const float f = exp2f(-(float)j * (13.287712379549449f / 16.f)); const float a = (float)p * f;
            float rev = a * 0.15915494309189535f; rev -= rintf(rev); const float ar = rev * 6.283185307179586f; R[i] = __cosf(ar); R[1024 + i] = __sinf(ar); }
        for (int i = F.tid; i < 64 * 8; i += NTHR) { const int p = i >> 3, j = i & 7; const float f = exp2f(-(float)j * (13.287712379549449f / 8.f)); const float a = (float)p * f;
            float rev = a * 0.15915494309189535f; rev -= rintf(rev); const float ar = rev * 6.283185307179586f; R[2048 + i] = __cosf(ar); R[2048 + 512 + i] = __sinf(ar); } }
    { u32x4* z = (u32x4*)((bf16_t*)(F.ws + WS_WIN) + (size_t)PROJ_W * 1024); const int n16 = (PROJ_WP - PROJ_W) * 1024 / 8;
      for (int i = blockIdx.x * NTHR + F.tid; i < n16; i += F.G * NTHR) z[i] = (u32x4){0u, 0u, 0u, 0u}; }
    LAS float* scr = (LAS float*)(F.lds + 32768) + F.wave * (64 * 33);
    constexpr int I_IN = 16 * 45, I_UQ = 6 * 24, I_UKV = 4 * 32, I_O = 16 * 32, I_GU1 = 16 * 64, I_D1 = 16 * 32;
    constexpr int NSMALL = I_IN + I_UQ + I_UKV + I_O, NITEMS = NSMALL + NE * (I_GU1 + I_D1);
    for (int it = gw; it < NITEMS; it += NGW) {
        int r = it;
        if (r < I_IN) { transpose_item(A.in[I_WIN], 1024, PROJ_W, (bf16_t*)(F.ws + WS_WIN), nullptr, scr, r, lane, MapWin()); continue; } r -= I_IN;
        if (r < I_UQ) { transpose_item(A.in[I_WUQ], 384, 768, (bf16_t*)(F.ws + WS_WUQ), A.in[I_GQA], scr, r, lane, MapWuq()); continue; } r -= I_UQ;
        if (r < I_UKV) { transpose_item(A.in[I_WUKV], 256, 1024, (bf16_t*)(F.ws + WS_WUKV), A.in[I_GKVA], scr, r, lane, MapId()); continue; } r -= I_UKV;
        if (r < I_O) { transpose_item(A.in[I_WO], 1024, 1024, (bf16_t*)(F.ws + WS_WO), nullptr, scr, r, lane, MapId()); continue; } r -= I_O;
        if (r < NE * I_GU1) { const int e = r / I_GU1; transpose_item(A.in[I_WGU] + (size_t)e * 1024 * 2048, 1024, 2048, (bf16_t*)(F.ws + WS_WGU) + (size_t)e * 2048 * 1024, nullptr, scr, r % I_GU1, lane, MapWgu()); continue; } r -= NE * I_GU1;
        { const int e = r / I_D1; transpose_item(A.in[I_WD] + (size_t)e * 1024 * 1024, 1024, 1024, (bf16_t*)(F.ws + WS_WD) + (size_t)e * 1024 * 1024, nullptr, scr, r % I_D1, lane, MapId()); }
    }
}

__device__ __forceinline__ void ph1_h(Frame& F, const Args& A) {
    LAS float* Av = (LAS float*)F.lds; LAS float* Bv = Av + 5 * 1024;
    const float* MODP = (const float*)(F.ws + WS_MODP); const float* bada = A.in[I_BADA]; const float* g = A.in[I_GMIXPRE];
    for (int i = F.tid; i < 5 * 1024; i += NTHR) { const int v = i >> 10, k = i & 1023; float sh = bada[k], sc = bada[1024 + k];
#pragma unroll
        for (int p = 0; p < 8; ++p) { sh += MODP[(size_t)(p * 5 + v) * 6144 + k]; sc += MODP[(size_t)(p * 5 + v) * 6144 + 1024 + k]; }
        Av[i] = g[k] * (1.f + sc); Bv[i] = sh; }
    { float* MODF = (float*)(F.ws + WS_MODF);
      for (int i = blockIdx.x * NTHR + F.tid; i < 5 * 6144; i += F.G * NTHR) { const int v = i / 6144, n = i % 6144; float s = bada[n];
#pragma unroll
          for (int p = 0; p < 8; ++p) s += MODP[(size_t)(p * 5 + v) * 6144 + n];
          MODF[i] = s; } }
    __syncthreads();
    const int gw = F.vcu * NWAVES + F.wave, NGW = F.G * NWAVES, lane = F.lane;
    bf16_t* H = (bf16_t*)(F.ws + WS_H);
    for (int row = gw; row < TT; row += NGW) {
        const int v = row < T ? (row >> 12) : 4; const float* src = row < T ? A.in[I_X] + (size_t)row * 1024 : A.in[I_CTX] + (size_t)(row - T) * 1024;
        f32x4 xv[4]; float ss = 0.f;
#pragma unroll
        for (int j = 0; j < 4; ++j) { xv[j] = *(const f32x4*)(src + 4 * lane + 256 * j); ss += xv[j].x * xv[j].x + xv[j].y * xv[j].y + xv[j].z * xv[j].z + xv[j].w * xv[j].w; }
        const float rstd = 1.f / sqrtf(wave_sum(ss) * (1.f / 1024.f) + EPS);
#pragma unroll
        for (int j = 0; j < 4; ++j) { const int k = 4 * lane + 256 * j; const f32x4 a = *(const LAS f32x4*)(Av + v * 1024 + k), b = *(const LAS f32x4*)(Bv + v * 1024 + k);
            u32x2 o; o.x = pk2(xv[j].x * rstd * a.x + b.x, xv[j].y * rstd * a.y + b.y); o.y = pk2(xv[j].z * rstd * a.z + b.z, xv[j].w * rstd * a.w + b.w);
            *(u32x2*)(H + (size_t)row * 1024 + k) = o; }
    }
}

__device__ __forceinline__ void ph6_route(Frame& F, const Args& A) {
    LAS float* Wr = (LAS float*)F.lds;
    LAS int* lcnt = (LAS int*)(F.lds + 147456); LAS int* gbase = lcnt + 32; LAS int* rte = gbase + 32; LAS int* rtr = rte + 256; LAS float* rtw = (LAS float*)(rtr + 256);
    const float* wr = A.in[I_WROUTER];
    for (int i = F.tid; i < 1024 * 8; i += NTHR) { const int k = i >> 3, q = i & 7; const f32x4 v = *(const f32x4*)(wr + k * 32 + 4 * q);
        const int rho = (k & 3) * 256 + ((k >> 2) & 63) + 64 * (k >> 8); *(LAS f32x4*)(Wr + rho * 36 + 4 * q) = v; }
    if (F.tid < 32) lcnt[F.tid] = 0;
    __syncthreads();
    const int lane = F.lane; const float* MODF = (const float*)(F.ws + WS_MODF);
    const bf16_t* Y = (const bf16_t*)(F.ws + WS_Y); float* X1 = (float*)(F.ws + WS_X1); bf16_t* H2 = (bf16_t*)(F.ws + WS_H2);
    const float* gpost = A.in[I_GMIXPOST]; const float* gpre = A.in[I_GFFNPRE]; const float* brt = A.in[I_BROUTER];
    int* COUNT = (int*)(F.ws + WS_CTL) + CW_COUNT; int* TOKL = (int*)(F.ws + WS_TOKL);
    int* TOPE = (int*)(F.ws + WS_TOPE); int* TOPR = (int*)(F.ws + WS_TOPR); float* TOPW = (float*)(F.ws + WS_TOPW);
    for (int base = F.vcu * 64; base < T; base += F.G * 64) {
        for (int rr = 0; rr < 8; ++rr) {
            const int rib = F.wave * 8 + rr, row = base + rib, b = row >> 12;
            const float* m2 = MODF + (size_t)b * 6144 + 2 * 1024; const float* m3 = m2 + 1024; const float* m4 = m3 + 1024;
            f32x4 xv[4], yv[4]; float ss = 0.f;
#pragma unroll
            for (int j = 0; j < 4; ++j) { const int k = 4 * lane + 256 * j; xv[j] = *(const f32x4*)(A.in[I_X] + (size_t)row * 1024 + k);
                const u32x2 yb = *(const u32x2*)(Y + (size_t)row * 1024 + k);
                yv[j].x = __uint_as_float(yb.x << 16); yv[j].y = __uint_as_float(yb.x & 0xffff0000u); yv[j].z = __uint_as_float(yb.y << 16); yv[j].w = __uint_as_float(yb.y & 0xffff0000u);
                ss += yv[j].x * yv[j].x + yv[j].y * yv[j].y + yv[j].z * yv[j].z + yv[j].w * yv[j].w; }
            const float rstd = 1.f / sqrtf(wave_sum(ss) * (1.f / 1024.f) + EPS);
            float s2 = 0.f;
#pragma unroll
            for (int j = 0; j < 4; ++j) { const int k = 4 * lane + 256 * j; const f32x4 gp = *(const f32x4*)(gpost + k), mm = *(const f32x4*)(m2 + k);
                xv[j].x += mm.x * (yv[j].x * rstd * gp.x); xv[j].y += mm.y * (yv[j].y * rstd * gp.y); xv[j].z += mm.z * (yv[j].z * rstd * gp.z); xv[j].w += mm.w * (yv[j].w * rstd * gp.w);
                *(f32x4*)(X1 + (size_t)row * 1024 + k) = xv[j];
                s2 += xv[j].x * xv[j].x + xv[j].y * xv[j].y + xv[j].z * xv[j].z + xv[j].w * xv[j].w; }
            const float rstd2 = 1.f / sqrtf(wave_sum(s2) * (1.f / 1024.f) + EPS);
            float acc[32];
#pragma unroll
            for (int e = 0; e < 32; ++e) acc[e] = 0.f;
#pragma unroll
            for (int j = 0; j < 4; ++j) { const int k = 4 * lane + 256 * j; const f32x4 gq = *(const f32x4*)(gpre + k), sh = *(const f32x4*)(m3 + k), sc = *(const f32x4*)(m4 + k);
                f32x4 h; h.x = xv[j].x * rstd2 * gq.x * (1.f + sc.x) + sh.x; h.y = xv[j].y * rstd2 * gq.y * (1.f + sc.y) + sh.y; h.z = xv[j].z * rstd2 * gq.z * (1.f + sc.z) + sh.z; h.w = xv[j].w * rstd2 * gq.w * (1.f + sc.w) + sh.w;
                u32x2 o; o.x = pk2(h.x, h.y); o.y = pk2(h.z, h.w); *(u32x2*)(H2 + (size_t)row * 1024 + k) = o;
#pragma unroll
                for (int i = 0; i < 4; ++i) { const float hv = h[i]; const LAS float* wrow = Wr + (i * 256 + lane + 64 * j) * 36;
#pragma unroll
                    for (int q = 0; q < 8; ++q) { const f32x4 w = *(const LAS f32x4*)(wrow + 4 * q); acc[4 * q] += hv * w.x; acc[4 * q + 1] += hv * w.y; acc[4 * q + 2] += hv * w.z; acc[4 * q + 3] += hv * w.w; } } }
#pragma unroll
            for (int i = 0; i < 16; ++i) { const bool up = (lane & 32) != 0; const float keep = up ? acc[i + 16] : acc[i], send = up ? acc[i] : acc[i + 16]; acc[i] = keep + __shfl_xor(send, 32); }
#pragma unroll
            for (int i = 0; i < 8; ++i) { const bool up = (lane & 16) != 0; const float keep = up ? acc[i + 8] : acc[i], send = up ? acc[i] : acc[i + 8]; acc[i] = keep + __shfl_xor(send, 16); }
#pragma unroll
            for (int i = 0; i < 4; ++i) { const bool up = (lane & 8) != 0; const float keep = up ? acc[i + 4] : acc[i], send = up ? acc[i] : acc[i + 4]; acc[i] = keep + __shfl_xor(send, 8); }
#pragma unroll
            for (int i = 0; i < 2; ++i) { const bool up = (lane & 4) != 0; const float keep = up ? acc[i + 2] : acc[i], send = up ? acc[i] : acc[i + 2]; acc[i] = keep + __shfl_xor(send, 4); }
            { const bool up = (lane & 2) != 0; const float keep = up ? acc[1] : acc[0], send = up ? acc[0] : acc[1]; acc[0] = keep + __shfl_xor(send, 2); }
            float lg = acc[0] + __shfl_xor(acc[0], 1);
            lg += brt[lane >> 1];
            float tv[4]; int te[4];
#pragma unroll
            for (int r = 0; r < 4; ++r) { const float m = wave_max(lg); const unsigned long long bal = __ballot(lg == m); const int wl = __ffsll((long long)bal) - 1; te[r] = wl >> 1; tv[r] = m; if ((lane >> 1) == te[r]) lg = -INFINITY; }
            const float e1 = expf(tv[1] - tv[0]), e2 = expf(tv[2] - tv[0]), e3 = expf(tv[3] - tv[0]); const float inv = 1.f / (1.f + e1 + e2 + e3);
            if (lane < 4) { const int e = lane == 0 ? te[0] : lane == 1 ? te[1] : lane == 2 ? te[2] : te[3]; const float w = (lane == 0 ? 1.f : lane == 1 ? e1 : lane == 2 ? e2 : e3) * inv;
                const int lr = __hip_atomic_fetch_add(&lcnt[e], 1, __ATOMIC_RELAXED, __HIP_MEMORY_SCOPE_WORKGROUP); rte[rib * 4 + lane] = e; rtr[rib * 4 + lane] = lr; rtw[rib * 4 + lane] = w; }
        }
        __syncthreads();
        if (F.tid < 32) { const int n = lcnt[F.tid]; gbase[F.tid] = n ? atomicAdd(&COUNT[F.tid], n) : 0; lcnt[F.tid] = 0; }
        __syncthreads();
        if (F.tid < 256) { const int rib = F.tid >> 2, row = base + rib; const int e = rte[F.tid], rk = gbase[e] + rtr[F.tid];
            TOKL[e * CAP_E + rk] = row; TOPE[row * 4 + (F.tid & 3)] = e; TOPR[row * 4 + (F.tid & 3)] = rk; TOPW[row * 4 + (F.tid & 3)] = rtw[F.tid]; }
        __syncthreads();
    }
}

__device__ __forceinline__ void ph9_final(Frame& F, const Args& A) {
    LAS int* ps = (LAS int*)F.lds;
    if (F.tid == 0) { const int* COUNT = (const int*)(F.ws + WS_CTL) + CW_COUNT; int a = 0; for (int e = 0; e < 32; ++e) { ps[e] = a; a += (COUNT[e] + 255) & ~255; } }
    __syncthreads();
    const int gw = F.vcu * NWAVES + F.wave, NGW = F.G * NWAVES, lane = F.lane;
    const float* MODF = (const float*)(F.ws + WS_MODF); const float* X1 = (const float*)(F.ws + WS_X1); const bf16_t* YS = (const bf16_t*)(F.ws + WS_YS);
    const int* TOPE = (const int*)(F.ws + WS_TOPE); const int* TOPR = (const int*)(F.ws + WS_TOPR); const float* TOPW = (const float*)(F.ws + WS_TOPW);
    const float* gfp = A.in[I_GFFNPOST];
    for (int row = gw; row < T; row += NGW) {
        const int b = row >> 12; const float* m5 = MODF + (size_t)b * 6144 + 5 * 1024;
        f32x4 f[4];
#pragma unroll
        for (int j = 0; j < 4; ++j) f[j] = (f32x4){0.f, 0.f, 0.f, 0.f};
#pragma unroll
        for (int kk = 0; kk < 4; ++kk) { const int e = TOPE[row * 4 + kk], slot = ps[e] + TOPR[row * 4 + kk]; const float w = TOPW[row * 4 + kk];
#pragma unroll
            for (int j = 0; j < 4; ++j) { const u32x2 yb = *(const u32x2*)(YS + (size_t)slot * 1024 + 4 * lane + 256 * j);
                f[j].x += w * __uint_as_float(yb.x << 16); f[j].y += w * __uint_as_float(yb.x & 0xffff0000u); f[j].z += w * __uint_as_float(yb.y << 16); f[j].w += w * __uint_as_float(yb.y & 0xffff0000u); } }
        float ss = 0.f;
#pragma unroll
        for (int j = 0; j < 4; ++j) ss += f[j].x * f[j].x + f[j].y * f[j].y + f[j].z * f[j].z + f[j].w * f[j].w;
        const float rstd = 1.f / sqrtf(wave_sum(ss) * (1.f / 1024.f) + EPS);
#pragma unroll
        for (int j = 0; j < 4; ++j) { const int k = 4 * lane + 256 * j; const f32x4 x1 = *(const f32x4*)(X1 + (size_t)row * 1024 + k), g = *(const f32x4*)(gfp + k), mm = *(const f32x4*)(m5 + k);
            f32x4 o; o.x = x1.x + mm.x * (f[j].x * rstd * g.x); o.y = x1.y + mm.y * (f[j].y * rstd * g.y); o.z = x1.z + mm.z * (f[j].z * rstd * g.z); o.w = x1.w + mm.w * (f[j].w * rstd * g.w);
            *(f32x4*)(F.out + (size_t)row * 1024 + k) = o; }
    }
}


namespace pg8 {
typedef short bf16x8 __attribute__((ext_vector_type(8)));
constexpr int BM = 256, BK = 64, HALF = 128, HTB = HALF * BK * 2, STAGE_BYTES = 8 * HTB, NXCD = 8, WGM = 8;
__host__ __device__ __forceinline__ int lds_byte(int r, int c) { const int st = (r >> 4) * 2 + (c >> 5), rr = r & 15, cc = c & 31, ob = rr * 64 + cc * 2; return st * 1024 + (ob ^ (((ob >> 9) & 1) << 5)); }
__host__ __device__ __forceinline__ void stage_rc(int b, int& R, int& C) { const int st = b / 1024, sb = b % 1024, swz = sb ^ (((sb >> 9) & 1) << 5); R = (st >> 1) * 16 + swz / 64; C = (st & 1) * 32 + (swz % 64) / 2; }
__host__ __device__ __forceinline__ int perm32(int rho) { const int n = rho >> 4, i = rho & 15; return 8 * (i >> 2) + 4 * n + (i & 3); }
struct Unit { int pm, pn, aux, idx; };
struct StaticOrder {
    int nM, nN, nwg, G, c;
    __device__ void init(int nM_, int nN_, int G_, int c_) { nM = nM_; nN = nN_; nwg = nM * nN; G = G_; c = c_; }
    __device__ bool next(int i, Unit& u) const {
        const long L = (long)i * G + c; if (L >= nwg) return false;
        int wgid = (int)L; { const int q = nwg / NXCD, r = nwg % NXCD, xcd = wgid % NXCD, off = wgid / NXCD; wgid = (xcd < r ? xcd * (q + 1) : r * (q + 1) + (xcd - r) * q) + off; }
        const int nig = WGM * nN, gid = wgid / nig, fm = gid * WGM, gsz = (nM - fm) < WGM ? (nM - fm) : WGM;
        u.pm = fm + ((wgid % nig) % gsz); u.pn = (wgid % nig) / gsz; u.aux = 0; u.idx = i; return true;
    }
};
__device__ __forceinline__ unsigned cvt_pk_bf16(float lo, float hi) { unsigned r; asm volatile("v_cvt_pk_bf16_f32 %0, %1, %2" : "=v"(r) : "v"(lo), "v"(hi)); return r; }

template <class P, bool ALIGN_EPI>
__device__ __forceinline__ void gemm_phase(LAS unsigned char* lds, const P& p) {
    const int tid = threadIdx.x, wid = __builtin_amdgcn_readfirstlane(tid >> 6), lane = tid & 63, wr = wid >> 2, wc = wid & 3, fr = lane & 15, fq = lane >> 4;
    const int K = p.K, nt = K / BK;
    int Rr[2], Cc[2]; unsigned voffB[2];
#pragma unroll
    for (int i = 0; i < 2; ++i) { int R, C; stage_rc(tid * 16 + i * 8192, R, C); const int Rb = (R & ~31) + perm32(R & 31); Rr[i] = R; Cc[i] = C; voffB[i] = (unsigned)(Rb * K + C) * 2u; }
    const size_t kstep = (size_t)(BK * 2);
    const size_t hstep = (size_t)HALF * K * 2;
    const unsigned ldsw = (unsigned)wid * 1024u;
    const int aoff = lds_byte(wr * 64 + fr, fq * 8), boff = lds_byte(wc * 32 + fr, fq * 8);
#define PG8_SA(b, h) (((b) * 2 + (h)) * HTB)
#define PG8_SB(b, h) ((4 + (b) * 2 + (h)) * HTB)
#define PG8_STAGE(bufoff, gbase, voff) do { _Pragma("unroll") for (int _i = 0; _i < 2; ++_i) \
        __builtin_amdgcn_global_load_lds((const unsigned*)((const char*)(gbase) + (voff)[_i]), (LAS unsigned*)(lds + (bufoff) + ldsw + _i * 8192), 16, 0, 0); } while (0)
#define PG8_LDA(dst, b, h) do { _Pragma("unroll") for (int m = 0; m < 4; ++m) _Pragma("unroll") for (int k = 0; k < 2; ++k) dst[m][k] = *(const LAS bf16x8*)(lds + PG8_SA(b, h) + aoff + m * 2048 + k * 1024); } while (0)
#define PG8_LDB(dst, b, h) do { _Pragma("unroll") for (int n = 0; n < 2; ++n) _Pragma("unroll") for (int k = 0; k < 2; ++k) dst[n][k] = *(const LAS bf16x8*)(lds + PG8_SB(b, h) + boff + n * 2048 + k * 1024); } while (0)
#define PG8_MMA(ai, bj, At, Bt) do { __builtin_amdgcn_s_setprio(1); _Pragma("unroll") for (int m = 0; m < 4; ++m) _Pragma("unroll") for (int n = 0; n < 2; ++n) _Pragma("unroll") for (int k = 0; k < 2; ++k) \
        acc[ai][bj][m][n] = __builtin_amdgcn_mfma_f32_16x16x32_bf16(Bt[n][k], At[m][k], acc[ai][bj][m][n], 0, 0, 0); __builtin_amdgcn_s_setprio(0); } while (0)
#define PG8_WAIT_V(n) asm volatile("s_waitcnt vmcnt(" #n ")" ::: "memory")
#define PG8_WAIT_L(n) asm volatile("s_waitcnt lgkmcnt(" #n ")" ::: "memory")
#define PG8_BAR __builtin_amdgcn_s_barrier()
#define PG8_SCHED __builtin_amdgcn_sched_barrier(0)
#define PG8_OFFS(dst, u) do { _Pragma("unroll") for (int _h = 0; _h < 2; ++_h) _Pragma("unroll") for (int _i = 0; _i < 2; ++_i) dst[_h][_i] = p.a_off(u, _h * HALF + Rr[_i]) + (unsigned)Cc[_i] * 2u; } while (0)
    Unit cur, nxt; int ui = 0;
    if (!p.next(0, cur)) return;
    bool has_next = p.next(1, nxt);
    unsigned offC[2][2], offN[2][2];
    PG8_OFFS(offC, cur);
    if (has_next) PG8_OFFS(offN, nxt); else { _Pragma("unroll") for (int h = 0; h < 2; ++h) _Pragma("unroll") for (int i = 0; i < 2; ++i) offN[h][i] = offC[h][i]; }
    f32x4 acc[2][2][4][2];
#pragma unroll
    for (int a = 0; a < 2; ++a)
#pragma unroll
        for (int b = 0; b < 2; ++b)
#pragma unroll
            for (int m = 0; m < 4; ++m)
#pragma unroll
                for (int n = 0; n < 2; ++n) acc[a][b][m][n] = (f32x4){0.f, 0.f, 0.f, 0.f};
    bf16x8 At[4][2], B0[2][2], B1[2][2];
    const char* const Ab = p.A; const char* cB = p.b_tile(cur);
    asm volatile("s_waitcnt vmcnt(0)" ::: "memory");
    PG8_STAGE(PG8_SB(0, 0), cB, voffB); PG8_STAGE(PG8_SB(0, 1), cB + hstep, voffB); PG8_STAGE(PG8_SA(0, 0), Ab, offC[0]); PG8_STAGE(PG8_SA(0, 1), Ab, offC[1]);
    if (wr == 1) PG8_BAR;
    PG8_WAIT_V(2); PG8_BAR;
    PG8_STAGE(PG8_SB(1, 0), cB + kstep, voffB); PG8_STAGE(PG8_SA(1, 0), Ab + kstep, offC[0]); PG8_STAGE(PG8_SB(1, 1), cB + hstep + kstep, voffB);
    PG8_WAIT_V(6); PG8_BAR;
    for (;;) {
        const char* nB = has_next ? p.b_tile(nxt) : cB;
        for (int t = 0; t < nt; t += 2) {
            const bool last = (t == nt - 2);
            const char* a1 = Ab + (size_t)(t + 1) * kstep;
            const char* a2 = last ? Ab : Ab + (size_t)(t + 2) * kstep; const char* b2 = last ? nB : cB + (size_t)(t + 2) * kstep;
            const char* a3 = a2 + kstep; const char* b3 = b2 + kstep;
            unsigned o2[2][2];
#pragma unroll
            for (int h = 0; h < 2; ++h)
#pragma unroll
                for (int i = 0; i < 2; ++i) o2[h][i] = last ? offN[h][i] : offC[h][i];
            PG8_LDB(B0, 0, 0); PG8_LDB(B1, 0, 1); PG8_SCHED; PG8_LDA(At, 0, 0); PG8_STAGE(PG8_SA(1, 1), a1, offC[1]);
            PG8_WAIT_V(8); PG8_WAIT_L(0); PG8_BAR; PG8_MMA(0, 0, At, B0); PG8_MMA(0, 1, At, B1); PG8_BAR; PG8_SCHED;
            PG8_LDA(At, 0, 1); PG8_STAGE(PG8_SB(0, 0), b2, voffB); PG8_STAGE(PG8_SB(0, 1), b2 + hstep, voffB); PG8_STAGE(PG8_SA(0, 0), a2, o2[0]);
            PG8_WAIT_V(8); PG8_WAIT_L(0); PG8_BAR; PG8_MMA(1, 0, At, B0); PG8_MMA(1, 1, At, B1); PG8_BAR; PG8_SCHED;
            PG8_LDB(B0, 1, 0); PG8_LDB(B1, 1, 1); PG8_SCHED; PG8_LDA(At, 1, 0); PG8_STAGE(PG8_SA(0, 1), a2, o2[1]);
            PG8_WAIT_V(8); PG8_WAIT_L(0); PG8_BAR; PG8_MMA(0, 0, At, B0); PG8_MMA(0, 1, At, B1); PG8_BAR; PG8_SCHED;
            PG8_LDA(At, 1, 1); PG8_STAGE(PG8_SB(1, 0), b3, voffB); PG8_STAGE(PG8_SB(1, 1), b3 + hstep, voffB); PG8_STAGE(PG8_SA(1, 0), a3, o2[0]);
            PG8_WAIT_V(8); PG8_WAIT_L(0); PG8_BAR; PG8_MMA(1, 0, At, B0); PG8_MMA(1, 1, At, B1); PG8_BAR; PG8_SCHED;
        }
        if constexpr (ALIGN_EPI) { if (wr == 0) PG8_BAR; }
        Unit nn; const bool has_nn = has_next && p.next(ui + 2, nn);
        unsigned offT[2][2];
        if (has_nn) PG8_OFFS(offT, nn);
        p.epi(acc, cur, wr, wc, fr, fq);
        if (!has_next) break;
#pragma unroll
        for (int a = 0; a < 2; ++a)
#pragma unroll
            for (int b = 0; b < 2; ++b)
#pragma unroll
                for (int m = 0; m < 4; ++m)
#pragma unroll
                    for (int n = 0; n < 2; ++n) acc[a][b][m][n] = (f32x4){0.f, 0.f, 0.f, 0.f};
        cur = nxt; cB = nB; ++ui;
#pragma unroll
        for (int h = 0; h < 2; ++h)
#pragma unroll
            for (int i = 0; i < 2; ++i) { offC[h][i] = offN[h][i]; offN[h][i] = has_nn ? offT[h][i] : offN[h][i]; }
        nxt = nn; has_next = has_nn;
        if constexpr (ALIGN_EPI) { if (wr == 1) PG8_BAR; }
    }
    PG8_WAIT_V(0);
    if constexpr (!ALIGN_EPI) { if (wr == 0) PG8_BAR; }
    PG8_BAR;
#undef PG8_SA
#undef PG8_SB
#undef PG8_STAGE
#undef PG8_LDA
#undef PG8_LDB
#undef PG8_MMA
#undef PG8_WAIT_V
#undef PG8_WAIT_L
#undef PG8_BAR
#undef PG8_SCHED
#undef PG8_OFFS
}
#define ACC8(v, A0, A1) float v[8] = {A0[0], A0[1], A0[2], A0[3], A1[0], A1[1], A1[2], A1[3]}
__device__ __forceinline__ u32x4 pack8(const float* v) { u32x4 w; w.x = cvt_pk_bf16(v[0], v[1]); w.y = cvt_pk_bf16(v[2], v[3]); w.z = cvt_pk_bf16(v[4], v[5]); w.w = cvt_pk_bf16(v[6], v[7]); return w; }

struct ProbWo {
    int K; const char* A; const char* Bt; bf16_t* Y; StaticOrder S;
    __device__ __forceinline__ bool next(int i, Unit& u) const { return S.next(i, u); }
    __device__ __forceinline__ unsigned a_off(const Unit& u, int r) const { return (unsigned)(u.pm * BM + r) * 2048u; }
    __device__ __forceinline__ const char* b_tile(const Unit& u) const { return Bt + (size_t)u.pn * BM * 2048; }
    __device__ __forceinline__ void epi(const f32x4 (&acc)[2][2][4][2], const Unit& u, int wr, int wc, int fr, int fq) const {
#pragma unroll
        for (int ai = 0; ai < 2; ++ai)
#pragma unroll
            for (int m = 0; m < 4; ++m) { const int row = u.pm * BM + ai * HALF + wr * 64 + m * 16 + fr;
#pragma unroll
                for (int bj = 0; bj < 2; ++bj) { const int c0 = u.pn * BM + bj * HALF + wc * 32 + 8 * fq; ACC8(v, acc[ai][bj][m][0], acc[ai][bj][m][1]);
                    *(u32x4*)(Y + (size_t)row * 1024 + c0) = pack8(v); } }
    }
};

__device__ __forceinline__ void rope4(float* v, const float* ct, const float* st, int idx) {
    const f32x4 cs = *(const f32x4*)(ct + idx), sn = *(const f32x4*)(st + idx);
#pragma unroll
    for (int j = 0; j < 4; ++j) { const float x1 = v[2 * j], x2 = v[2 * j + 1]; v[2 * j] = x1 * cs[j] - x2 * sn[j]; v[2 * j + 1] = x1 * sn[j] + x2 * cs[j]; }
}
struct ProbProj {
    int K; const char* A; const char* Bt; StaticOrder S; unsigned char* ws;
    __device__ __forceinline__ bool next(int i, Unit& u) const { return S.next(i, u); }
    __device__ __forceinline__ unsigned a_off(const Unit& u, int r) const { return (unsigned)(u.pm * BM + r) * 2048u; }
    __device__ __forceinline__ const char* b_tile(const Unit& u) const { return Bt + (size_t)u.pn * BM * 2048; }
    __device__ __forceinline__ void epi(const f32x4 (&acc)[2][2][4][2], const Unit& u, int wr, int wc, int fr, int fq) const {
        const float* R = (const float*)(ws + WS_ROPE);
        bf16_t* QA = (bf16_t*)(ws + WS_QA); bf16_t* KA = (bf16_t*)(ws + WS_KA); bf16_t* VAt = (bf16_t*)(ws + WS_VAT); bf16_t* CQ = (bf16_t*)(ws + WS_CQ); bf16_t* CKV = (bf16_t*)(ws + WS_CKV); bf16_t* KB = (bf16_t*)(ws + WS_KB);
#pragma unroll
        for (int ai = 0; ai < 2; ++ai)
#pragma unroll
            for (int m = 0; m < 4; ++m) { const int row = u.pm * BM + ai * HALF + wr * 64 + m * 16 + fr; const bool lat = row < T; int b, key; row_bk(row, b, key);
                const int t = row & 4095, rr = t >> 6, cc = t & 63;
#pragma unroll
                for (int bj = 0; bj < 2; ++bj) { const int cbase = u.pn * BM + bj * HALF + wc * 32, c0 = cbase + 8 * fq; ACC8(v, acc[ai][bj][m][0], acc[ai][bj][m][1]);
                    if (cbase < 640) { const int hh = c0 >> 6, pos0 = c0 & 63, i0 = pos0 >> 1;
                        if (lat) rope4(v, R, R + 1024, i0 < 16 ? rr * 16 + i0 : cc * 16 + (i0 - 16));
                        if (cbase < 512) { if (lat) {
#pragma unroll
                                for (int j = 0; j < 8; ++j) v[j] *= A_SCALE_L2;
                                *(u32x4*)(QA + (size_t)row * 512 + c0) = pack8(v); } }
                        else *(u32x4*)(KA + ((size_t)(b * 2 + (hh - 8)) * NKEY + key) * 64 + pos0) = pack8(v);
                    } else if (cbase < 768) { const int g = (c0 - 640) >> 6, d0 = (c0 - 640) & 63; bf16_t* dst = VAt + ((size_t)(b * 2 + g) * 64 + d0) * NKEY + kpos_of(key);
#pragma unroll
                        for (int j = 0; j < 8; ++j) dst[(size_t)j * NKEY] = (bf16_t)f2bf(v[j]);
                    } else if (cbase < 1152) { if (lat) *(u32x4*)(CQ + (size_t)row * 384 + (c0 - 768)) = pack8(v);
                    } else if (cbase < 1408) { *(u32x4*)(CKV + (size_t)row * 256 + (c0 - 1152)) = pack8(v);
                    } else if (cbase < 1440) { const int pos0 = c0 - 1408, i0 = pos0 >> 1;
                        if (lat) rope4(v, R + 2048, R + 2560, i0 < 8 ? rr * 8 + i0 : cc * 8 + (i0 - 8));
                        const u32x4 w = pack8(v);
#pragma unroll
                        for (int h = 0; h < 8; ++h) *(u32x4*)(KB + ((size_t)(b * 8 + h) * NKEY + key) * 96 + 64 + pos0) = w; }
                } }
    }
};
template <class P>
__device__ __forceinline__ void rstd_prepass(const P& p, LAS float* rs, int maxu) {
    Unit u; const int tid = threadIdx.x, r = tid >> 1, hf = tid & 1, K = p.K;
    for (int ui = 0; ui < maxu && p.next(ui, u); ++ui) {
        const bf16_t* src = (const bf16_t*)(p.A + p.a_off(u, r)) + hf * (K / 2); float ss = 0.f;
        for (int k = 0; k < K / 2; k += 8) { const u32x4 w = *(const u32x4*)(src + k);
#pragma unroll
            for (int j = 0; j < 4; ++j) { const float a = __uint_as_float(w[j] << 16), bq = __uint_as_float(w[j] & 0xffff0000u); ss += a * a + bq * bq; } }
        ss += __shfl_xor(ss, 1);
        if (hf == 0) rs[ui * 256 + r] = 1.f / sqrtf(ss / (float)K + EPS);
    }
    __syncthreads();
}
struct ProbQ {
    int K; const char* A; const char* Bt; StaticOrder S; unsigned char* ws; const LAS float* rs;
    __device__ __forceinline__ bool next(int i, Unit& u) const { return S.next(i, u); }
    __device__ __forceinline__ unsigned a_off(const Unit& u, int r) const { return (unsigned)(u.pm * BM + r) * 768u; }
    __device__ __forceinline__ const char* b_tile(const Unit& u) const { return Bt + (size_t)u.pn * BM * 768; }
    __device__ __forceinline__ void epi(const f32x4 (&acc)[2][2][4][2], const Unit& u, int wr, int wc, int fr, int fq) const {
        const float* R = (const float*)(ws + WS_ROPE); bf16_t* QB = (bf16_t*)(ws + WS_QB);
#pragma unroll
        for (int ai = 0; ai < 2; ++ai)
#pragma unroll
            for (int m = 0; m < 4; ++m) { const int rit = ai * HALF + wr * 64 + m * 16 + fr, row = u.pm * BM + rit; const int t = row & 4095, rr = t >> 6, cc = t & 63;
                const float sc = rs[u.idx * 256 + rit] * MLA_SCALE_L2;
#pragma unroll
                for (int bj = 0; bj < 2; ++bj) { const int c0 = u.pn * BM + bj * HALF + wc * 32 + 8 * fq, i = c0 % 96; ACC8(v, acc[ai][bj][m][0], acc[ai][bj][m][1]);
                    if (i >= 64) { const int i0 = (i - 64) >> 1; rope4(v, R + 2048, R + 2560, i0 < 8 ? rr * 8 + i0 : cc * 8 + (i0 - 8)); }
#pragma unroll
                    for (int j = 0; j < 8; ++j) v[j] *= sc;
                    *(u32x4*)(QB + (size_t)row * 768 + c0) = pack8(v); } }
    }
};
struct ProbKV {
    int K; const char* A; const char* Bt; StaticOrder S; unsigned char* ws; const LAS float* rs;
    __device__ __forceinline__ bool next(int i, Unit& u) const { return S.next(i, u); }
    __device__ __forceinline__ unsigned a_off(const Unit& u, int r) const { return (unsigned)(u.pm * BM + r) * 512u; }
    __device__ __forceinline__ const char* b_tile(const Unit& u) const { return Bt + (size_t)u.pn * BM * 512; }
    __device__ __forceinline__ void epi(const f32x4 (&acc)[2][2][4][2], const Unit& u, int wr, int wc, int fr, int fq) const {
        bf16_t* KB = (bf16_t*)(ws + WS_KB); bf16_t* VBt = (bf16_t*)(ws + WS_VBT);
#pragma unroll
        for (int ai = 0; ai < 2; ++ai)
#pragma unroll
            for (int m = 0; m < 4; ++m) { const int rit = ai * HALF + wr * 64 + m * 16 + fr, row = u.pm * BM + rit; int b, key; row_bk(row, b, key);
                const float sc = rs[u.idx * 256 + rit];
#pragma unroll
                for (int bj = 0; bj < 2; ++bj) { const int c0 = u.pn * BM + bj * HALF + wc * 32 + 8 * fq, h = c0 >> 7, i = c0 & 127; ACC8(v, acc[ai][bj][m][0], acc[ai][bj][m][1]);
#pragma unroll
                    for (int j = 0; j < 8; ++j) v[j] *= sc;
                    if (i < 64) *(u32x4*)(KB + ((size_t)(b * 8 + h) * NKEY + key) * 96 + i) = pack8(v);
                    else { bf16_t* dst = VBt + ((size_t)(b * 8 + h) * 64 + (i - 64)) * NKEY + kpos_of(key);
#pragma unroll
                        for (int j = 0; j < 8; ++j) dst[(size_t)j * NKEY] = (bf16_t)f2bf(v[j]); } } }
    }
};
struct MoeTab { const LAS int* tile_e; const LAS int* tstart; const LAS int* cnt; };
__device__ __forceinline__ MoeTab moe_tables(LAS unsigned char* base, const int* COUNT) {
    LAS int* te = (LAS int*)base; LAS int* ts = te + 288; LAS int* cn = ts + 33;
    if (threadIdx.x == 0) { int a = 0; for (int e = 0; e < NE; ++e) { const int c = COUNT[e], n = (c + 255) >> 8; cn[e] = c; ts[e] = a; for (int j = 0; j < n; ++j) te[a + j] = e; a += n; } ts[32] = a; }
    __syncthreads();
    MoeTab t; t.tile_e = te; t.tstart = ts; t.cnt = cn; return t;
}
template <int NN>
__device__ __forceinline__ bool moe_next(const MoeTab& tb, int i, int G, int c, Unit& u) {
    const int nwg = tb.tstart[32] * NN; const long L = (long)i * G + c; if (L >= nwg) return false;
    int wgid = (int)L; { const int q = nwg / NXCD, r = nwg % NXCD, xcd = wgid % NXCD, off = wgid / NXCD; wgid = (xcd < r ? xcd * (q + 1) : r * (q + 1) + (xcd - r) * q) + off; }
    u.pm = wgid / NN; u.pn = wgid % NN; u.aux = tb.tile_e[u.pm]; u.idx = i; return true;
}
struct ProbGu {
    int K; const char* A; const char* Bt; MoeTab tb; int G, c; const int* tokl; const float* bias; bf16_t* ACT;
    __device__ __forceinline__ bool next(int i, Unit& u) const { return moe_next<8>(tb, i, G, c, u); }
    __device__ __forceinline__ unsigned a_off(const Unit& u, int r) const { const int e = u.aux, sl = (u.pm - tb.tstart[e]) * BM + r; const int tok = sl < tb.cnt[e] ? tokl[e * CAP_E + sl] : 0; return (unsigned)tok * 2048u; }
    __device__ __forceinline__ const char* b_tile(const Unit& u) const { return Bt + ((size_t)u.aux * 2048 + (size_t)u.pn * BM) * 2048; }
    __device__ __forceinline__ void epi(const f32x4 (&acc)[2][2][4][2], const Unit& u, int wr, int wc, int fr, int fq) const {
        const int gc = u.pn * 128 + wc * 32 + 8 * fq; const float* bg = bias + (size_t)u.aux * 2048 + gc; float bgv[8], blv[8];
#pragma unroll
        for (int j = 0; j < 8; ++j) { bgv[j] = bg[j]; blv[j] = bg[1024 + j]; }
#pragma unroll
        for (int ai = 0; ai < 2; ++ai)
#pragma unroll
            for (int m = 0; m < 4; ++m) { const int slot = u.pm * BM + ai * HALF + wr * 64 + m * 16 + fr; ACC8(g, acc[ai][0][m][0], acc[ai][0][m][1]); ACC8(l, acc[ai][1][m][0], acc[ai][1][m][1]);
#pragma unroll
                for (int j = 0; j < 8; ++j) { const float gg = fminf(g[j] + bgv[j], 7.f), ll = fminf(fmaxf(l[j] + blv[j], -7.f), 7.f);
                    g[j] = (ll + 1.f) * gg * __builtin_amdgcn_rcpf(1.f + __expf(-1.702f * gg)); }
                *(u32x4*)(ACT + (size_t)slot * 1024 + gc) = pack8(g); }
    }
};
struct ProbDn {
    int K; const char* A; const char* Bt; MoeTab tb; int G, c; const float* bias; bf16_t* YS;
    __device__ __forceinline__ bool next(int i, Unit& u) const { return moe_next<4>(tb, i, G, c, u); }
    __device__ __forceinline__ unsigned a_off(const Unit& u, int r) const { return (unsigned)(u.pm * BM + r) * 2048u; }
    __device__ __forceinline__ const char* b_tile(const Unit& u) const { return Bt + ((size_t)u.aux * 1024 + (size_t)u.pn * BM) * 2048; }
    __device__ __forceinline__ void epi(const f32x4 (&acc)[2][2][4][2], const Unit& u, int wr, int wc, int fr, int fq) const {
#pragma unroll
        for (int bj = 0; bj < 2; ++bj) { const int c0 = u.pn * BM + bj * HALF + wc * 32 + 8 * fq; const float* bp = bias + (size_t)u.aux * 1024 + c0; float bv[8];
#pragma unroll
            for (int j = 0; j < 8; ++j) bv[j] = bp[j];
#pragma unroll
            for (int ai = 0; ai < 2; ++ai)
#pragma unroll
                for (int m = 0; m < 4; ++m) { const int slot = u.pm * BM + ai * HALF + wr * 64 + m * 16 + fr; ACC8(v, acc[ai][bj][m][0], acc[ai][bj][m][1]);
#pragma unroll
                    for (int j = 0; j < 8; ++j) v[j] += bv[j];
                    *(u32x4*)(YS + (size_t)slot * 1024 + c0) = pack8(v); } }
    }
};
}


namespace att {
typedef short bf16x8 __attribute__((ext_vector_type(8)));
typedef float f32x16 __attribute__((ext_vector_type(16)));
constexpr int VSTR = 144;
__device__ __forceinline__ int crow(int r, int hi) { return (r & 3) + 8 * (r >> 2) + 4 * hi; }
template <int DQK, bool WIN>
__device__ __forceinline__ void attn_unit(LAS unsigned char* lds, const bf16_t* Qw, int qpitch, const bf16_t* Kp, const bf16_t* Vtp, float m0, float l0, int ntiles, int lt_lo, int jq, int trow0, bf16_t* Ow) {
    constexpr int KSTR = DQK * 2 + 16, KBYTES = 64 * KSTR, VBYTES = 64 * VSTR, CH = DQK / 8, NC = DQK / 16;
    const int tid = threadIdx.x, lane = tid & 63, r32 = lane & 31, hi = lane >> 5;
    bf16x8 qf[NC];
#pragma unroll
    for (int c = 0; c < NC; ++c) qf[c] = *(const bf16x8*)(Qw + (size_t)r32 * qpitch + c * 16 + hi * 8);
    const int krow0 = tid / CH, kch0 = tid % CH, krow1 = (512 + tid) / CH, kch1 = (512 + tid) % CH;
    u32x4 kreg0, kreg1, vreg;
#define TILE_KEY0(t) ((WIN && (t) >= 4) ? (CTX + 64 * (lt_lo + (t) - 4)) : 64 * (t))
#define GLOAD(t) do { const int k0_ = TILE_KEY0(t); kreg0 = *(const u32x4*)(Kp + (size_t)(k0_ + krow0) * DQK + kch0 * 8); \
        if (DQK == 96 && tid < 256) kreg1 = *(const u32x4*)(Kp + (size_t)(k0_ + krow1) * DQK + kch1 * 8); \
        vreg = *(const u32x4*)(Vtp + (size_t)(tid >> 3) * NKEY + k0_ + (tid & 7) * 8); } while (0)
#define LSTORE(b) do { *(LAS u32x4*)(lds + (b) * KBYTES + krow0 * KSTR + kch0 * 16) = kreg0; \
        if (DQK == 96 && tid < 256) *(LAS u32x4*)(lds + (b) * KBYTES + krow1 * KSTR + kch1 * 16) = kreg1; \
        *(LAS u32x4*)(lds + 2 * KBYTES + (b) * VBYTES + (tid >> 3) * VSTR + (tid & 7) * 16) = vreg; } while (0)
    GLOAD(0); LSTORE(0);
    __syncthreads();
    float m = m0, l = l0; f32x16 o0 = {}, o1 = {};
    for (int t = 0; t < ntiles; ++t) {
        const int buf = t & 1;
        if (t + 1 < ntiles) GLOAD(t + 1);
        const LAS unsigned char* kb = lds + buf * KBYTES + r32 * KSTR + hi * 16;
        f32x16 p0 = {}, p1 = {};
#pragma unroll
        for (int c = 0; c < NC; ++c) { const bf16x8 a0 = *(const LAS bf16x8*)(kb + c * 32), a1 = *(const LAS bf16x8*)(kb + 32 * KSTR + c * 32);
            p0 = __builtin_amdgcn_mfma_f32_32x32x16_bf16(a0, qf[c], p0, 0, 0, 0); p1 = __builtin_amdgcn_mfma_f32_32x32x16_bf16(a1, qf[c], p1, 0, 0, 0); }
        if (WIN && t >= 4) { const int lt = lt_lo + t - 4;
            if (lt == jq - 2 || lt == jq + 2) { const int tq = trow0 + r32;
#pragma unroll
                for (int r = 0; r < 16; ++r) { const int kl = 64 * lt + crow(r, hi); if (abs(tq - kl) > 128) p0[r] = -INFINITY; if (abs(tq - (kl + 32)) > 128) p1[r] = -INFINITY; } } }
        float rm = fmaxf(p0[0], p1[0]);
#pragma unroll
        for (int r = 1; r < 16; ++r) rm = fmaxf(rm, fmaxf(p0[r], p1[r]));
        rm = fmaxf(rm, __shfl_xor(rm, 32));
        const float mn = fmaxf(m, rm), alpha = __builtin_amdgcn_exp2f(m - mn); m = mn;
        float rsum = 0.f;
#pragma unroll
        for (int r = 0; r < 16; ++r) { p0[r] = __builtin_amdgcn_exp2f(p0[r] - mn); p1[r] = __builtin_amdgcn_exp2f(p1[r] - mn); rsum += p0[r] + p1[r]; }
        l = l * alpha + rsum;
#pragma unroll
        for (int r = 0; r < 16; ++r) { o0[r] *= alpha; o1[r] *= alpha; }
        bf16x8 pf[4];
#pragma unroll
        for (int c = 0; c < 2; ++c) { u32x4 w0, w1;
#pragma unroll
            for (int j = 0; j < 4; ++j) { w0[j] = pg8::cvt_pk_bf16(p0[8 * c + 2 * j], p0[8 * c + 2 * j + 1]); w1[j] = pg8::cvt_pk_bf16(p1[8 * c + 2 * j], p1[8 * c + 2 * j + 1]); }
            pf[c] = __builtin_bit_cast(bf16x8, w0); pf[2 + c] = __builtin_bit_cast(bf16x8, w1); }
        const LAS unsigned char* vb = lds + 2 * KBYTES + buf * VBYTES + r32 * VSTR + hi * 16;
#pragma unroll
        for (int c = 0; c < 4; ++c) { const bf16x8 v0 = *(const LAS bf16x8*)(vb + c * 32), v1 = *(const LAS bf16x8*)(vb + 32 * VSTR + c * 32);
            o0 = __builtin_amdgcn_mfma_f32_32x32x16_bf16(v0, pf[c], o0, 0, 0, 0); o1 = __builtin_amdgcn_mfma_f32_32x32x16_bf16(v1, pf[c], o1, 0, 0, 0); }
        if (t + 1 < ntiles) LSTORE(buf ^ 1);
        __syncthreads();
    }
    l += __shfl_xor(l, 32);
    const float inv = 1.f / l;
    bf16_t* orow = Ow + (size_t)r32 * 1024;
#pragma unroll
    for (int g = 0; g < 4; ++g) { u32x2 w; w.x = pg8::cvt_pk_bf16(o0[4 * g] * inv, o0[4 * g + 1] * inv); w.y = pg8::cvt_pk_bf16(o0[4 * g + 2] * inv, o0[4 * g + 3] * inv); *(u32x2*)(orow + 8 * g + 4 * hi) = w;
        u32x2 w2; w2.x = pg8::cvt_pk_bf16(o1[4 * g] * inv, o1[4 * g + 1] * inv); w2.y = pg8::cvt_pk_bf16(o1[4 * g + 2] * inv, o1[4 * g + 3] * inv); *(u32x2*)(orow + 32 + 8 * g + 4 * hi) = w2; }
#undef TILE_KEY0
#undef GLOAD
#undef LSTORE
}
}


#define XB_TMO      128
#define XB_XCNT(j)  (256  + 64 * (j))
#define XB_XSUB(j)  (1280 + 64 * (j))
#define XB_XGEN(j)  (2304 + 64 * (j))
#define XB_TOP      3328
#define XB_TOPGEN   3392
#define XCD_BAR_WORDS 3456
#define XB_SPIN_CAP (1u << 18)
__device__ __forceinline__ unsigned xb_ld(unsigned* p)              { return __hip_atomic_load(p, __ATOMIC_RELAXED, __HIP_MEMORY_SCOPE_AGENT); }
__device__ __forceinline__ unsigned xb_add(unsigned* p, unsigned v) { return __hip_atomic_fetch_add(p, v, __ATOMIC_RELAXED, __HIP_MEMORY_SCOPE_AGENT); }
__device__ __forceinline__ unsigned xb_xcc_id() { return (unsigned)__builtin_amdgcn_s_getreg((3 << 11) | 20) & 0xFu; }
#define XB_SPIN(cond, bar) do { unsigned _sp = 0; while (cond) { __builtin_amdgcn_s_sleep(1); \
    if ((++_sp & 255u) == 0u) { if (xb_ld(&(bar)[XB_TMO])) break; if (_sp > XB_SPIN_CAP) { atomicAdd(&(bar)[XB_TMO], 1u); break; } } } } while (0)
struct XcdBarrier { unsigned* bar; unsigned x; volatile LAS unsigned* st; };
__device__ __forceinline__ XcdBarrier xcd_barrier_post(unsigned* bar, volatile LAS unsigned* st) {
    XcdBarrier b; b.bar = bar; b.x = xb_xcc_id(); b.st = st;
    if (threadIdx.x == 0) (void)xb_add(&bar[XB_XCNT(b.x)], 1u);
    return b;
}
__device__ __forceinline__ void xcd_barrier_complete(unsigned* bar, unsigned x, unsigned& nloc, unsigned& nx) {
    const unsigned G = gridDim.x * gridDim.y * gridDim.z;
    unsigned sum, cnt, mine, sp = 0u;
    for (;;) {
        sum = 0u; cnt = 0u; mine = 0u;
#pragma unroll
        for (unsigned j = 0; j < 16; ++j) { const unsigned c = xb_ld(&bar[XB_XCNT(j)]); sum += c; cnt += (c > 0u) ? 1u : 0u; mine = (j == x) ? c : mine; }
        if (sum == G) break;
        __builtin_amdgcn_s_sleep(1);
        if ((++sp & 255u) == 0u) { if (xb_ld(&bar[XB_TMO])) break; if (sp > XB_SPIN_CAP) { atomicAdd(&bar[XB_TMO], 1u); break; } }
    }
    nloc = mine > 0u ? mine : 1u; nx = cnt > 0u ? cnt : 1u;
}
__device__ __forceinline__ void xcd_barrier(const XcdBarrier& b) {
    asm volatile("s_waitcnt vmcnt(0)" ::: "memory");
    __syncthreads();
    if (threadIdx.x == 0) {
        unsigned* bar = b.bar;
        __builtin_amdgcn_s_waitcnt(0);
        unsigned nloc = b.st[0], nx = b.st[1];
        if (nloc == 0u) { xcd_barrier_complete(bar, b.x, nloc, nx); b.st[0] = nloc; b.st[1] = nx; }
        const unsigned old = xb_add(&bar[XB_XSUB(b.x)], 1u);
        const unsigned gen = old / nloc;
        if (old + 1u == (gen + 1u) * nloc) {
            __builtin_amdgcn_fence(__ATOMIC_RELEASE, "agent");
            asm volatile("s_waitcnt vmcnt(0)" ::: "memory");
            const unsigned og = xb_add(&bar[XB_TOP], 1u);
            const unsigned tg = og / nx;
            if (og + 1u == (tg + 1u) * nx) xb_add(&bar[XB_TOPGEN], 1u);
            else XB_SPIN(xb_ld(&bar[XB_TOPGEN]) == tg, bar);
            __builtin_amdgcn_fence(__ATOMIC_ACQUIRE, "agent");
            xb_add(&bar[XB_XGEN(b.x)], 1u);
            asm volatile("s_waitcnt vmcnt(0)" ::: "memory");
        } else {
            XB_SPIN(xb_ld(&bar[XB_XGEN(b.x)]) == gen, bar);
            __builtin_amdgcn_fence(__ATOMIC_ACQUIRE, "agent");
            asm volatile("s_waitcnt vmcnt(0)" ::: "memory");
        }
    }
    __syncthreads();
}

__global__ void __launch_bounds__(NTHR, 2) mega(Args args) {
    extern __shared__ __attribute__((aligned(16))) unsigned char lds_raw[];
    Frame F; F.lds = (LAS unsigned char*)lds_raw; F.tid = threadIdx.x; F.lane = F.tid & 63; F.wave = __builtin_amdgcn_readfirstlane(F.tid >> 6);
    F.G = gridDim.x; { const int bx = blockIdx.x; F.vcu = (F.G % 8 == 0) ? (bx % 8) * (F.G / 8) + bx / 8 : bx; }
    F.ws = args.ws; F.out = args.out;
    const int lo = args.ph_lo, hi = args.ph_hi;
    volatile LAS unsigned* xbw = (volatile LAS unsigned*)(F.lds + LDS_BYTES - 16);
    if (F.tid < 4) xbw[F.tid] = 0u;
    __syncthreads();
    XcdBarrier bar = xcd_barrier_post((unsigned*)(F.ws + WS_CTL) + CW_BAR, xbw);
#define IN(k) (lo <= (k) && (k) < hi)
#define SEAM(k) do { if (IN(k) && IN((k) + 1)) xcd_barrier(bar); } while (0)
    if (IN(0)) { ph0_prologue(F, args); }
    SEAM(0);
    if (IN(1)) { ph1_h(F, args); }
    SEAM(1);
    if (IN(2)) { pg8::ProbProj P; P.K = 1024; P.A = (const char*)(F.ws + WS_H); P.Bt = (const char*)(F.ws + WS_WIN); P.S.init(TT / 256, PROJ_WP / 256, F.G, (int)blockIdx.x); P.ws = F.ws;
        pg8::gemm_phase<pg8::ProbProj, true>(F.lds, P); }
    SEAM(2);
    if (IN(3)) { LAS float* rsq = (LAS float*)(F.lds + 131072); LAS float* rskv = rsq + 256;
        pg8::ProbQ Q; Q.K = 384; Q.A = (const char*)(F.ws + WS_CQ); Q.Bt = (const char*)(F.ws + WS_WUQ); Q.S.init(T / 256, 3, F.G, (int)blockIdx.x); Q.ws = F.ws; Q.rs = rsq;
        pg8::ProbKV V; V.K = 256; V.A = (const char*)(F.ws + WS_CKV); V.Bt = (const char*)(F.ws + WS_WUKV); V.S.init(TT / 256, 4, F.G, (int)((blockIdx.x + 64) % F.G)); V.ws = F.ws; V.rs = rskv;
        pg8::rstd_prepass(Q, rsq, 1); pg8::rstd_prepass(V, rskv, 2);
        pg8::gemm_phase<pg8::ProbQ, true>(F.lds, Q); pg8::gemm_phase<pg8::ProbKV, true>(F.lds, V); }
    SEAM(3);
    if (IN(4)) {
        const bf16_t* QB = (const bf16_t*)(F.ws + WS_QB); const bf16_t* KB = (const bf16_t*)(F.ws + WS_KB); const bf16_t* VBt = (const bf16_t*)(F.ws + WS_VBT); bf16_t* ATT = (bf16_t*)(F.ws + WS_ATT);
        const bf16_t* QA = (const bf16_t*)(F.ws + WS_QA); const bf16_t* KA = (const bf16_t*)(F.ws + WS_KA); const bf16_t* VAt = (const bf16_t*)(F.ws + WS_VAT);
        for (int u = F.vcu; u < 512; u += F.G) { const int bh = u >> 4, qt = u & 15, b = bh >> 3, h = bh & 7, row0 = b * SEQ + qt * 256 + F.wave * 32;
            att::attn_unit<96, false>(F.lds, QB + (size_t)row0 * 768 + h * 96, 768, KB + (size_t)bh * NKEY * 96, VBt + (size_t)bh * 64 * NKEY, -INFINITY, 0.f, NKEY / 64, 0, 0, 0, ATT + (size_t)row0 * 1024 + 512 + h * 64); }
        for (int u = F.vcu; u < 512; u += F.G) { const int bg = u >> 6, j = u & 63, b = bg >> 1, g = bg & 1, hq = g * 4 + (F.wave >> 1), trow0 = 64 * j + 32 * (F.wave & 1), row0 = b * SEQ + trow0;
            const int lt_lo = j - 2 < 0 ? 0 : j - 2, lt_hi = j + 2 > 63 ? 63 : j + 2;
            att::attn_unit<64, true>(F.lds, QA + (size_t)row0 * 512 + hq * 64, 512, KA + (size_t)bg * NKEY * 64, VAt + (size_t)bg * 64 * NKEY, args.in[I_SINK][hq] * LOG2E, (F.lane < 32) ? 1.f : 0.f, 4 + (lt_hi - lt_lo + 1), lt_lo, j, trow0, ATT + (size_t)row0 * 1024 + hq * 64); }
    }
    SEAM(4);
    if (IN(5)) { pg8::ProbWo P; P.K = 1024; P.A = (const char*)(F.ws + WS_ATT); P.Bt = (const char*)(F.ws + WS_WO); P.Y = (bf16_t*)(F.ws + WS_Y); P.S.init(T / 256, 4, F.G, (int)blockIdx.x);
        pg8::gemm_phase<pg8::ProbWo, true>(F.lds, P); }
    SEAM(5);
    if (IN(6)) { ph6_route(F, args); }
    SEAM(6);
    if (IN(7)) { pg8::MoeTab tb = pg8::moe_tables(F.lds + 131072, (const int*)(F.ws + WS_CTL) + CW_COUNT);
        pg8::ProbGu P; P.K = 1024; P.A = (const char*)(F.ws + WS_H2); P.Bt = (const char*)(F.ws + WS_WGU); P.tb = tb; P.G = F.G; P.c = (int)blockIdx.x; P.tokl = (const int*)(F.ws + WS_TOKL); P.bias = args.in[I_BGU]; P.ACT = (bf16_t*)(F.ws + WS_ACT);
        pg8::gemm_phase<pg8::ProbGu, true>(F.lds, P); }
    SEAM(7);
    if (IN(8)) { pg8::MoeTab tb = pg8::moe_tables(F.lds + 131072, (const int*)(F.ws + WS_CTL) + CW_COUNT);
        pg8::ProbDn P; P.K = 1024; P.A = (const char*)(F.ws + WS_ACT); P.Bt = (const char*)(F.ws + WS_WD); P.tb = tb; P.G = F.G; P.c = (int)blockIdx.x; P.bias = args.in[I_BD]; P.YS = (bf16_t*)(F.ws + WS_YS);
        pg8::gemm_phase<pg8::ProbDn, true>(F.lds, P); }
    SEAM(8);
    if (IN(9)) { ph9_final(F, args); }
#undef IN
#undef SEAM
}

namespace nv {
template <class P, bool DUAL>
__global__ void __launch_bounds__(256) ngemm(P p) {
    __shared__ float sA[16][68]; __shared__ float sB[16][68]; __shared__ float sB2[16][68];
    const int z = blockIdx.z, M = p.M(z), N = p.N, K = p.K, m0 = blockIdx.y * 64, n0 = blockIdx.x * 64;
    if (m0 >= M) return;
    const int tid = threadIdx.x, tx = tid & 15, ty = tid >> 4;
    float acc[4][4], acc2[4][4];
#pragma unroll
    for (int i = 0; i < 4; ++i)
#pragma unroll
        for (int j = 0; j < 4; ++j) { acc[i][j] = 0.f; acc2[i][j] = 0.f; }
    for (int k0 = 0; k0 < K; k0 += 16) {
#pragma unroll
        for (int i = 0; i < 4; ++i) { const int id = tid + 256 * i, r = id >> 4, kk = id & 15; sA[kk][r] = (m0 + r < M) ? p.a(z, m0 + r, k0 + kk) : 0.f; }
#pragma unroll
        for (int i = 0; i < 4; ++i) { const int id = tid + 256 * i, kk = id >> 6, cc = id & 63; const bool ok = n0 + cc < N; sB[kk][cc] = ok ? p.b(z, k0 + kk, n0 + cc) : 0.f; if (DUAL) sB2[kk][cc] = ok ? p.b2(z, k0 + kk, n0 + cc) : 0.f; }
        __syncthreads();
#pragma unroll
        for (int kk = 0; kk < 16; ++kk) { float a[4], b[4], b2[4];
#pragma unroll
            for (int i = 0; i < 4; ++i) { a[i] = sA[kk][ty * 4 + i]; b[i] = sB[kk][tx * 4 + i]; b2[i] = DUAL ? sB2[kk][tx * 4 + i] : 0.f; }
#pragma unroll
            for (int i = 0; i < 4; ++i)
#pragma unroll
                for (int j = 0; j < 4; ++j) { acc[i][j] += a[i] * b[j]; if (DUAL) acc2[i][j] += a[i] * b2[j]; } }
        __syncthreads();
    }
#pragma unroll
    for (int i = 0; i < 4; ++i)
#pragma unroll
        for (int j = 0; j < 4; ++j) { const int row = m0 + ty * 4 + i, col = n0 + tx * 4 + j; if (row < M && col < N) p.store(z, row, col, acc[i][j], acc2[i][j]); }
}
struct PProj { const bf16_t* H; const float* W; float* O; int N, K;
    __device__ int M(int) const { return TT; } __device__ float a(int, int r, int k) const { return bf2f(H[(size_t)r * 1024 + k]); }
    __device__ float b(int, int k, int n) const { return W[(size_t)k * PROJ_W + n]; } __device__ float b2(int, int, int) const { return 0.f; }
    __device__ void store(int, int r, int c, float v, float) const { O[(size_t)r * PROJ_W + c] = v; } };
struct PLat { const bf16_t* A; const float* rstd; const float* g; const float* W; float* O; int N, K, Mrows;
    __device__ int M(int) const { return Mrows; } __device__ float a(int, int r, int k) const { return bf2f(A[(size_t)r * K + k]) * rstd[r] * g[k]; }
    __device__ float b(int, int k, int n) const { return W[(size_t)k * N + n]; } __device__ float b2(int, int, int) const { return 0.f; }
    __device__ void store(int, int r, int c, float v, float) const { O[(size_t)r * N + c] = v; } };
struct PWo { const bf16_t* A; const float* W; bf16_t* O; int N, K;
    __device__ int M(int) const { return T; } __device__ float a(int, int r, int k) const { return bf2f(A[(size_t)r * 1024 + k]); }
    __device__ float b(int, int k, int n) const { return W[(size_t)k * 1024 + n]; } __device__ float b2(int, int, int) const { return 0.f; }
    __device__ void store(int, int r, int c, float v, float) const { O[(size_t)r * 1024 + c] = (bf16_t)f2bf(v); } };
struct PGu { const bf16_t* H2; const int* tokl; const int* cnt; const int* ps; const float* W; const float* bias; bf16_t* ACT; int N, K;
    __device__ int M(int z) const { return cnt[z]; } __device__ float a(int z, int r, int k) const { return bf2f(H2[(size_t)tokl[z * CAP_E + r] * 1024 + k]); }
    __device__ float b(int z, int k, int n) const { return W[((size_t)z * 1024 + k) * 2048 + n]; } __device__ float b2(int z, int k, int n) const { return W[((size_t)z * 1024 + k) * 2048 + 1024 + n]; }
    __device__ void store(int z, int r, int c, float g, float l) const { g += bias[z * 2048 + c]; l += bias[z * 2048 + 1024 + c]; g = fminf(g, 7.f); l = fminf(fmaxf(l, -7.f), 7.f);
        const float act = (l + 1.f) * (g / (1.f + expf(-1.702f * g))); ACT[(size_t)(ps[z] + r) * 1024 + c] = (bf16_t)f2bf(act); } };
struct PDn { const bf16_t* ACT; const int* cnt; const int* ps; const float* W; const float* bias; bf16_t* YS; int N, K;
    __device__ int M(int z) const { return cnt[z]; } __device__ float a(int z, int r, int k) const { return bf2f(ACT[(size_t)(ps[z] + r) * 1024 + k]); }
    __device__ float b(int z, int k, int n) const { return W[((size_t)z * 1024 + k) * 1024 + n]; } __device__ float b2(int, int, int) const { return 0.f; }
    __device__ void store(int z, int r, int c, float v, float) const { YS[(size_t)(ps[z] + r) * 1024 + c] = (bf16_t)f2bf(v + bias[z * 1024 + c]); } };

__global__ void k_padstart(const int* cnt, int* ps) { if (threadIdx.x == 0) { int a = 0; for (int e = 0; e < 32; ++e) { ps[e] = a; a += (cnt[e] + 255) & ~255; } ps[32] = a; } }
__global__ void k_rstd(const bf16_t* A, int K, int M, float* out) { const int r = blockIdx.x * blockDim.x + threadIdx.x; if (r >= M) return; float s = 0.f; for (int k = 0; k < K; ++k) { const float v = bf2f(A[(size_t)r * K + k]); s += v * v; } out[r] = 1.f / sqrtf(s / (float)K + EPS); }

__global__ void k_proj_scatter(const float* P, const float* R, bf16_t* QA, bf16_t* KA, bf16_t* VAt, bf16_t* CQ, bf16_t* CKV, bf16_t* KB) {
    const int idx = blockIdx.x * blockDim.x + threadIdx.x; if (idx >= TT * PROJ_W) return;
    const int row = idx / PROJ_W, n = idx % PROJ_W; const float* pr = P + (size_t)row * PROJ_W; const float v = pr[n];
    int b, key; row_bk(row, b, key); const bool lat = row < T; const int t = row & 4095, rr = t >> 6, cc = t & 63;
    const float* cosA = R; const float* sinA = R + 1024; const float* cosB = R + 2048; const float* sinB = R + 2560;
    if (n < 640) {
        const int hh = n >> 6, i = n & 63, ih = i & 31; const bool second = i >= 32; float o = v;
        if (lat) { const float x1 = pr[(hh << 6) + ih], x2 = pr[(hh << 6) + ih + 32]; const int pidx = ih < 16 ? rr * 16 + ih : cc * 16 + (ih - 16); const float c = cosA[pidx], s = sinA[pidx]; o = second ? (x1 * s + x2 * c) : (x1 * c - x2 * s); }
        const int pos = 2 * ih + (second ? 1 : 0);
        if (n < 512) { if (lat) QA[(size_t)row * 512 + hh * 64 + pos] = (bf16_t)f2bf(o * A_SCALE_L2); }
        else { const int g = hh - 8; KA[((size_t)(b * 2 + g) * NKEY + key) * 64 + pos] = (bf16_t)f2bf(o); }
    } else if (n < 768) { const int g = (n - 640) >> 6, d = (n - 640) & 63; VAt[((size_t)(b * 2 + g) * 64 + d) * NKEY + kpos_of(key)] = (bf16_t)f2bf(v);
    } else if (n < 1152) { if (lat) CQ[(size_t)row * 384 + (n - 768)] = (bf16_t)f2bf(v);
    } else if (n < 1408) { CKV[(size_t)row * 256 + (n - 1152)] = (bf16_t)f2bf(v);
    } else { const int i = n - 1408, ih = i & 15; const bool second = i >= 16; float o = v;
        if (lat) { const float x1 = pr[1408 + ih], x2 = pr[1408 + ih + 16]; const int pidx = ih < 8 ? rr * 8 + ih : cc * 8 + (ih - 8); const float c = cosB[pidx], s = sinB[pidx]; o = second ? (x1 * s + x2 * c) : (x1 * c - x2 * s); }
        const int pos = 2 * ih + (second ? 1 : 0);
        for (int h = 0; h < 8; ++h) KB[((size_t)(b * 8 + h) * NKEY + key) * 96 + 64 + pos] = (bf16_t)f2bf(o); }
}
__global__ void k_mla_scatter(const float* Q32, const float* KV32, const float* R, bf16_t* QB, bf16_t* KB, bf16_t* VBt) {
    const int idx = blockIdx.x * blockDim.x + threadIdx.x;
    const float* cosB = R + 2048; const float* sinB = R + 2560;
    if (idx < T * 768) { const int row = idx / 768, n = idx % 768, h = n / 96, i = n % 96; const float* pr = Q32 + (size_t)row * 768; const int t = row & 4095, rr = t >> 6, cc = t & 63;
        if (i < 64) QB[(size_t)row * 768 + n] = (bf16_t)f2bf(pr[n] * MLA_SCALE_L2);
        else { const int r = i - 64, ih = r & 15; const bool second = r >= 16; const float x1 = pr[h * 96 + 64 + ih], x2 = pr[h * 96 + 64 + ih + 16]; const int pidx = ih < 8 ? rr * 8 + ih : cc * 8 + (ih - 8);
            const float c = cosB[pidx], s = sinB[pidx]; const float o = second ? (x1 * s + x2 * c) : (x1 * c - x2 * s); QB[(size_t)row * 768 + h * 96 + 64 + 2 * ih + (second ? 1 : 0)] = (bf16_t)f2bf(o * MLA_SCALE_L2); } }
    if (idx < TT * 1024) { const int row = idx >> 10, n = idx & 1023, h = n >> 7, i = n & 127; int b, key; row_bk(row, b, key); const float v = KV32[idx];
        if (i < 64) KB[((size_t)(b * 8 + h) * NKEY + key) * 96 + i] = (bf16_t)f2bf(v);
        else VBt[((size_t)(b * 8 + h) * 64 + (i - 64)) * NKEY + kpos_of(key)] = (bf16_t)f2bf(v); }
}
template <int DQK, bool WIN>
__global__ void __launch_bounds__(256) k_attn(const bf16_t* Q, int qpitch, const bf16_t* Kb, const bf16_t* Vt, int nqh, int group, const float* sink, bf16_t* O, int ocol0) {
    const int hq = blockIdx.y % nqh, b = blockIdx.y / nqh, t = blockIdx.x * 256 + threadIdx.x, row = b * SEQ + t, kh = hq / group, nkh = nqh / group;
    const bf16_t* qp = Q + (size_t)row * qpitch + hq * DQK; const bf16_t* Kp = Kb + (size_t)(b * nkh + kh) * NKEY * DQK; const bf16_t* Vp = Vt + (size_t)(b * nkh + kh) * 64 * NKEY;
    float q[DQK];
#pragma unroll
    for (int d = 0; d < DQK; ++d) q[d] = bf2f(qp[d]);
    const int t0 = blockIdx.x * 256; const int klo = WIN ? max(0, t0 - 128) : 0, khi = WIN ? min(SEQ - 1, t0 + 255 + 128) : SEQ - 1;
    float m = sink ? sink[hq] * LOG2E : -1e30f;
    for (int pass = 0; pass < 2; ++pass) {
        float l = (pass == 1 && sink) ? exp2f(sink[hq] * LOG2E - m) : 0.f; float o[64];
#pragma unroll
        for (int d = 0; d < 64; ++d) o[d] = 0.f;
        for (int seg = 0; seg < 2; ++seg) { const int k0 = seg == 0 ? 0 : CTX + klo, k1 = seg == 0 ? CTX : CTX + khi + 1;
            for (int key = k0; key < k1; ++key) {
                const bool valid = (seg == 0) || !WIN || (abs(t - (key - CTX)) <= 128);
                const bf16_t* kr = Kp + (size_t)key * DQK; float s = 0.f;
#pragma unroll
                for (int d = 0; d < DQK; ++d) s += q[d] * bf2f(kr[d]);
                if (!valid) continue;
                if (pass == 0) { m = fmaxf(m, s); }
                else { const float p = exp2f(s - m); l += p; const int kp = kpos_of(key);
#pragma unroll
                    for (int d = 0; d < 64; ++d) o[d] += p * bf2f(Vp[(size_t)d * NKEY + kp]); } } }
        if (pass == 1) { const float inv = 1.f / l;
#pragma unroll
            for (int d = 0; d < 64; ++d) O[(size_t)row * 1024 + ocol0 + hq * 64 + d] = (bf16_t)f2bf(o[d] * inv); }
    }
}
}

extern "C" void kernel_launch(void* const* d_in, const int* in_sizes, int n_in, void* d_out, int out_size, void* d_ws, size_t ws_size, hipStream_t stream) {
    static int grid = 0;
    if (grid == 0) {
        int dev = 0, cus = 0;
        hipGetDevice(&dev); hipDeviceGetAttribute(&cus, hipDeviceAttributeMultiprocessorCount, dev);
        hipFuncSetAttribute((const void*)mega, hipFuncAttributeMaxDynamicSharedMemorySize, LDS_BYTES);
        grid = cus > 0 ? cus : 256;
        if (n_in != 23 || ws_size < WS_END) { fprintf(stderr, "kernel_launch: unexpected n_in %d / ws %zu\n", n_in, ws_size); }
    }
    unsigned char* ws = (unsigned char*)d_ws;
    hipMemsetAsync(ws + WS_CTL, 0, CTL_BYTES, stream);
    Args a{};
    for (int i = 0; i < 23; ++i) a.in[i] = (const float*)d_in[i];
    a.out = (float*)d_out; a.ws = ws;
    auto phase = [&](int p) { a.ph_lo = p; a.ph_hi = p + 1; hipLaunchKernelGGL(mega, dim3(grid), dim3(NTHR), LDS_BYTES, stream, a); };
    const float* R = (const float*)(ws + WS_ROPE);
    bf16_t *H = (bf16_t*)(ws + WS_H), *QA = (bf16_t*)(ws + WS_QA), *KA = (bf16_t*)(ws + WS_KA), *VAt = (bf16_t*)(ws + WS_VAT), *CQ = (bf16_t*)(ws + WS_CQ), *CKV = (bf16_t*)(ws + WS_CKV);
    bf16_t *QB = (bf16_t*)(ws + WS_QB), *KB = (bf16_t*)(ws + WS_KB), *VBt = (bf16_t*)(ws + WS_VBT), *ATT = (bf16_t*)(ws + WS_ATT), *Y = (bf16_t*)(ws + WS_Y), *H2 = (bf16_t*)(ws + WS_H2);
    bf16_t *ACT = (bf16_t*)(ws + WS_ACT), *YS = (bf16_t*)(ws + WS_YS);
    float *PROJ32 = (float*)(ws + WS_PROJ32), *Q32 = (float*)(ws + WS_Q32), *KV32 = (float*)(ws + WS_KV32), *RSTD = (float*)(ws + WS_RSTD);
    int* COUNT = (int*)(ws + WS_CTL) + CW_COUNT; int* PS = COUNT + 64; int* TOKL = (int*)(ws + WS_TOKL);
#if ONE_LAUNCH
    a.ph_lo = 0; a.ph_hi = 10; hipLaunchKernelGGL(mega, dim3(grid), dim3(NTHR), LDS_BYTES, stream, a);
    return;
#endif
    phase(0);
    phase(1);
#if FAST_S2
    phase(2);
#else
    { nv::PProj p{H, a.in[I_WIN], PROJ32, PROJ_W, 1024}; hipLaunchKernelGGL((nv::ngemm<nv::PProj, false>), dim3((PROJ_W + 63) / 64, TT / 64, 1), dim3(256), 0, stream, p);
      hipLaunchKernelGGL(nv::k_proj_scatter, dim3((TT * PROJ_W + 255) / 256), dim3(256), 0, stream, PROJ32, R, QA, KA, VAt, CQ, CKV, KB); }
#endif
#if FAST_S3
    phase(3);
#else
    { hipLaunchKernelGGL(nv::k_rstd, dim3(T / 256), dim3(256), 0, stream, CQ, 384, T, RSTD);
      hipLaunchKernelGGL(nv::k_rstd, dim3(TT / 256), dim3(256), 0, stream, CKV, 256, TT, RSTD + T);
      nv::PLat pq{CQ, RSTD, a.in[I_GQA], a.in[I_WUQ], Q32, 768, 384, T}; hipLaunchKernelGGL((nv::ngemm<nv::PLat, false>), dim3(768 / 64, T / 64, 1), dim3(256), 0, stream, pq);
      nv::PLat pk{CKV, RSTD + T, a.in[I_GKVA], a.in[I_WUKV], KV32, 1024, 256, TT}; hipLaunchKernelGGL((nv::ngemm<nv::PLat, false>), dim3(1024 / 64, TT / 64, 1), dim3(256), 0, stream, pk);
      hipLaunchKernelGGL(nv::k_mla_scatter, dim3((TT * 1024 + 255) / 256), dim3(256), 0, stream, Q32, KV32, R, QB, KB, VBt); }
#endif
#if FAST_S4
    phase(4);
#else
    { hipLaunchKernelGGL((nv::k_attn<64, true>), dim3(SEQ / 256, NB * 8), dim3(256), 0, stream, QA, 512, KA, VAt, 8, 4, a.in[I_SINK], ATT, 0);
      hipLaunchKernelGGL((nv::k_attn<96, false>), dim3(SEQ / 256, NB * 8), dim3(256), 0, stream, QB, 768, KB, VBt, 8, 1, (const float*)nullptr, ATT, 512); }
#endif
#if FAST_S5
    phase(5);
#else
    { nv::PWo p{ATT, a.in[I_WO], Y, 1024, 1024}; hipLaunchKernelGGL((nv::ngemm<nv::PWo, false>), dim3(1024 / 64, T / 64, 1), dim3(256), 0, stream, p); }
#endif
    phase(6);
    hipLaunchKernelGGL(nv::k_padstart, dim3(1), dim3(64), 0, stream, COUNT, PS);
#if FAST_S7
    phase(7);
#else
    {
      nv::PGu pg{H2, TOKL, COUNT, PS, a.in[I_WGU], a.in[I_BGU], ACT, 1024, 1024}; hipLaunchKernelGGL((nv::ngemm<nv::PGu, true>), dim3(1024 / 64, CAP_E / 64, NE), dim3(256), 0, stream, pg); }
#endif
#if FAST_S8
    phase(8);
#else
    {
      nv::PDn pd{ACT, COUNT, PS, a.in[I_WD], a.in[I_BD], YS, 1024, 1024}; hipLaunchKernelGGL((nv::ngemm<nv::PDn, false>), dim3(1024 / 64, CAP_E / 64, NE), dim3(256), 0, stream, pd); }
#endif
    phase(9);
}
```
